# Optimizing an MI355X kernel written in HIP

```python
import math
import jax, jax.numpy as jnp
from jax import lax
import numpy as np


D_MODEL = 1024
BATCH = 8
SEQ = 2048
DEPTH = 1

ATT_WIDTH = D_MODEL // 2
RWKV_WIDTH = D_MODEL - ATT_WIDTH
DA_HEAD_DIM = 64
DA_HEADS = ATT_WIDTH // (2 * DA_HEAD_DIM)
DA_V_DIM = 2 * DA_HEAD_DIM
Q_BLOCK = 128
RW_HEAD = 64
RW_HEADS = RWKV_WIDTH // RW_HEAD
DECAY_LORA = 64
ICLR_LORA = 64
GATE_LORA = 128
RWKV_COLS = 3 * RWKV_WIDTH + 2 * DECAY_LORA + 2 * ICLR_LORA + GATE_LORA
IN_COLS = 3 * ATT_WIDTH + RWKV_COLS
GN_EPS = 64e-5
PEER_HEADS = 8
PEER_NKEYS = 128
PEER_EXPERTS = PEER_NKEYS * PEER_NKEYS
PEER_TOPK = 16
PEER_QDIM = 256
PEER_SUBDIM = PEER_QDIM // 2
PEER_CHUNK = 128
NORM_EPS = 1e-6

kernel_name = "hymba_diffattn_rwkv7_peer_adaln"


def rms_norm(x, g, eps=NORM_EPS):
    xf = x.astype(jnp.float32)
    y = xf * lax.rsqrt(jnp.mean(xf * xf, axis=-1, keepdims=True) + eps)
    return (y * g.astype(jnp.float32)).astype(x.dtype)


def alibi_slopes(n):
    return jnp.asarray([2.0 ** (-8.0 * (h + 1) / n) for h in range(n)], jnp.float32)


def lambda_init_fn(layer_idx):
    return 0.8 - 0.6 * math.exp(-0.3 * layer_idx)


def diff_attention(q, k, v, qn_g, kn_g, lam, subln_g, lambda_init):
    B, S = q.shape[0], q.shape[1]
    q = rms_norm(q, qn_g)
    k = rms_norm(k, kn_g)
    lf = lam.astype(jnp.float32)
    lam_full = jnp.exp(jnp.sum(lf[0] * lf[1])) - jnp.exp(jnp.sum(lf[2] * lf[3])) + lambda_init
    slopes = alibi_slopes(DA_HEADS)
    scale = DA_HEAD_DIM ** -0.5
    kpos = jnp.arange(S)
    n_blk = S // Q_BLOCK
    qb = q.reshape(B, n_blk, Q_BLOCK, DA_HEADS, 2, DA_HEAD_DIM).transpose(1, 0, 2, 3, 4, 5)
    starts = jnp.arange(n_blk) * Q_BLOCK

    def block(args):
        qblk, start = args
        s = jnp.einsum('bqhcd,bkhcd->bhcqk', qblk, k, preferred_element_type=jnp.float32) * scale
        qpos = start + jnp.arange(Q_BLOCK)
        dist = jnp.abs(qpos[:, None] - kpos[None, :]).astype(jnp.float32)
        s = s - slopes[None, :, None, None, None] * dist[None, None, None]
        p = jax.nn.softmax(s, axis=-1)
        a = p[:, :, 0] - lam_full * p[:, :, 1]
        return jnp.einsum('bhqk,bkhv->bqhv', a.astype(v.dtype), v)

    o = lax.map(block, (qb, starts))
    o = o.transpose(1, 0, 2, 3, 4).reshape(B, S, DA_HEADS, DA_V_DIM)
    o = rms_norm(o, subln_g) * (1.0 - lambda_init)
    return o.reshape(B, S, DA_HEADS * DA_V_DIM)


def centred_shift(p, mu):
    prev = jnp.pad(p, ((0, 0), (1, 0), (0, 0)))[:, :-1]
    nxt = jnp.pad(p, ((0, 0), (0, 1), (0, 0)))[:, 1:]
    return p + mu[0] * (prev - p) + mu[1] * (nxt - p)


def rwkv7_bidir(p, mu, w0, w2, a0, a2, g2, k_k, k_a, r_k, ln_g, ln_b):
    B, S = p.shape[0], p.shape[1]
    out_dtype = p.dtype
    p = centred_shift(p.astype(jnp.float32), mu.astype(jnp.float32))
    W = RWKV_WIDTH
    o1 = 3 * W
    o2 = o1 + 2 * DECAY_LORA
    o3 = o2 + 2 * ICLR_LORA
    r, k, v = p[..., :W], p[..., W:2 * W], p[..., 2 * W:o1]
    wd = p[..., o1:o2].reshape(B, S, 2, DECAY_LORA)
    ad = p[..., o2:o3].reshape(B, S, 2, ICLR_LORA)
    gd = p[..., o3:]
    f = lambda t: t.astype(jnp.float32)
    w = -jax.nn.softplus(-(f(w0) + jnp.einsum('bsdr,drc->bsdc', jnp.tanh(wd), f(w2)))) - 0.5
    decay = jnp.exp(-jnp.exp(w))
    a = jax.nn.sigmoid(f(a0) + jnp.einsum('bsdr,drc->bsdc', ad, f(a2)))
    g = jax.nn.sigmoid(gd) @ f(g2)
    kk = (k * f(k_k)).reshape(B, S, RW_HEADS, RW_HEAD)
    kk = kk / jnp.maximum(jnp.sqrt(jnp.sum(kk * kk, -1, keepdims=True)), 1e-12)
    k_dir = k[:, :, None, :] * (1.0 + (a - 1.0) * f(k_a))
    hd = lambda t: t.reshape(t.shape[:-1] + (RW_HEADS, RW_HEAD))
    rh, kh, vh = hd(r), hd(k), hd(v)

    def shared_dirs(t):
        return jnp.stack([t, t[:, ::-1]], 0).transpose(2, 0, 1, 3, 4)

    def split_dirs(t):
        return jnp.stack([t[:, :, 0], t[:, ::-1, 1]], 0).transpose(2, 0, 1, 3, 4)

    xs = (shared_dirs(rh), split_dirs(hd(decay)), split_dirs(hd(k_dir)), shared_dirs(vh),
          shared_dirs(kk), split_dirs(hd(a)))

    def step(state, inp):
        r_t, dec_t, k_t, v_t, kk_t, a_t = inp
        sa = jnp.einsum('dbhvk,dbhk->dbhv', state, -kk_t)
        new = (state * dec_t[..., None, :] + sa[..., :, None] * (kk_t * a_t)[..., None, :]
               + v_t[..., :, None] * k_t[..., None, :])
        y_fwd = jnp.einsum('bhvk,bhk->bhv', new[0], r_t[0])
        y_bwd = jnp.einsum('bhvk,bhk->bhv', state[1], r_t[1])
        return new, jnp.stack([y_fwd, y_bwd], 0)

    s0 = jnp.zeros((2, B, RW_HEADS, RW_HEAD, RW_HEAD), jnp.float32)
    _, ys = lax.scan(step, s0, xs)
    y = (ys[:, 0] + ys[::-1, 1]).transpose(1, 0, 2, 3)
    mean = jnp.mean(y, -1, keepdims=True)
    var = jnp.mean(jnp.square(y - mean), -1, keepdims=True)
    yn = ((y - mean) * lax.rsqrt(var + GN_EPS)).reshape(B, S, W) * f(ln_g) + f(ln_b)
    bonus = (jnp.sum(rh * kh * f(r_k), -1, keepdims=True) * vh).reshape(B, S, W)
    return ((yn + bonus) * g).astype(out_dtype)


def peer_ffn(h, wq, keys, U, V):
    B, S, D = h.shape
    T = B * S
    hf = h.reshape(T, D)
    q = (hf @ wq).reshape(T, PEER_HEADS, 2, PEER_SUBDIM)
    s = jnp.einsum('thpd,hpkd->thpk', q, keys, preferred_element_type=jnp.float32)
    s1, i1 = lax.top_k(s[:, :, 0], PEER_TOPK)
    s2, i2 = lax.top_k(s[:, :, 1], PEER_TOPK)
    cand = (s1[..., :, None] + s2[..., None, :]).reshape(T, PEER_HEADS, PEER_TOPK * PEER_TOPK)
    sc, ci = lax.top_k(cand, PEER_TOPK)
    e1 = jnp.take_along_axis(i1, ci // PEER_TOPK, axis=-1)
    e2 = jnp.take_along_axis(i2, ci % PEER_TOPK, axis=-1)
    idx = e1 * PEER_NKEYS + e2
    gates = jax.nn.softmax(sc, axis=-1)
    n_chunks = T // PEER_CHUNK

    def chunk(args):
        xc, ic, gc = args
        act = jax.nn.gelu(jnp.einsum('chkd,cd->chk', U[ic], xc, preferred_element_type=jnp.float32),
                          approximate=False)
        return jnp.einsum('chk,chkd->cd', (gc * act).astype(V.dtype), V[ic])

    out = lax.map(chunk, (hf.reshape(n_chunks, PEER_CHUNK, D),
                          idx.reshape(n_chunks, PEER_CHUNK, PEER_HEADS, PEER_TOPK),
                          gates.reshape(n_chunks, PEER_CHUNK, PEER_HEADS, PEER_TOPK)))
    return out.reshape(B, S, D).astype(h.dtype)


def setup_inputs(seed: int = 0) -> dict:
    key = jax.random.key(seed)
    ks = jax.random.split(key, 32)
    f32 = jnp.float32
    L, D = DEPTH, D_MODEL
    nrm = lambda k, shape, s: jax.random.normal(k, shape, f32) * s
    gain = lambda k, shape: 1.0 + 0.05 * jax.random.normal(k, shape, f32)
    return {
        'x': nrm(ks[0], (BATCH, SEQ, D), 1.0),
        'c': nrm(ks[1], (BATCH, D), 1.0),
        'ada_w': nrm(ks[2], (L, D, 6 * D), D ** -0.5),
        'ada_b': nrm(ks[3], (L, 6 * D), 0.02),
        'norm1_g': gain(ks[4], (L, D)),
        'w_in': nrm(ks[5], (L, D, IN_COLS), D ** -0.5),
        'da_qnorm_g': gain(ks[6], (L, DA_HEAD_DIM)),
        'da_knorm_g': gain(ks[7], (L, DA_HEAD_DIM)),
        'da_lambda': nrm(ks[8], (L, 4, DA_HEAD_DIM), 0.1),
        'da_subln_g': gain(ks[9], (L, DA_V_DIM)),
        'rw_shift_mu': jax.random.uniform(ks[10], (L, 2, RWKV_COLS), f32, 0.0, 0.5),
        'rw_w0': jax.random.uniform(ks[11], (L, 2, RWKV_WIDTH), f32, -6.0, 1.0),
        'rw_w2': nrm(ks[12], (L, 2, DECAY_LORA, RWKV_WIDTH), 0.1),
        'rw_a0': nrm(ks[13], (L, 2, RWKV_WIDTH), 0.3),
        'rw_a2': nrm(ks[14], (L, 2, ICLR_LORA, RWKV_WIDTH), 0.1),
        'rw_g2': nrm(ks[15], (L, GATE_LORA, RWKV_WIDTH), GATE_LORA ** -0.5),
        'rw_k_k': 0.85 + 0.05 * jax.random.normal(ks[16], (L, RWKV_WIDTH), f32),
        'rw_k_a': gain(ks[17], (L, RWKV_WIDTH)),
        'rw_r_k': nrm(ks[18], (L, RW_HEADS, RW_HEAD), 0.1),
        'rw_ln_g': gain(ks[19], (L, RWKV_WIDTH)),
        'rw_ln_b': nrm(ks[20], (L, RWKV_WIDTH), 0.02),
        'w_out': nrm(ks[21], (L, D, D), D ** -0.5),
        'norm2_g': gain(ks[22], (L, D)),
        'peer_wq': nrm(ks[23], (L, D, PEER_HEADS * PEER_QDIM), D ** -0.5),
        'peer_keys': nrm(ks[24], (L, PEER_HEADS, 2, PEER_NKEYS, PEER_SUBDIM), PEER_SUBDIM ** -0.5),
        'peer_u': nrm(ks[25], (L, PEER_EXPERTS, D), D ** -0.5),
        'peer_v': nrm(ks[26], (L, PEER_EXPERTS, D), PEER_TOPK ** -0.5),
    }


def reference(x, c, ada_w, ada_b, norm1_g, w_in, da_qnorm_g, da_knorm_g, da_lambda, da_subln_g,
              rw_shift_mu, rw_w0, rw_w2, rw_a0, rw_a2, rw_g2, rw_k_k, rw_k_a, rw_r_k, rw_ln_g, rw_ln_b,
              w_out, norm2_g, peer_wq, peer_keys, peer_u, peer_v):
    B, S, D = x.shape
    for l in range(DEPTH):
        mod = (jax.nn.silu(c) @ ada_w[l] + ada_b[l]).reshape(B, 6, D)
        shift1, scale1, gate1, shift2, scale2, gate2 = [mod[:, i, None, :] for i in range(6)]
        h = rms_norm(x, norm1_g[l]) * (1.0 + scale1) + shift1
        p = h @ w_in[l]
        q = p[..., :ATT_WIDTH].reshape(B, S, DA_HEADS, 2, DA_HEAD_DIM)
        k = p[..., ATT_WIDTH:2 * ATT_WIDTH].reshape(B, S, DA_HEADS, 2, DA_HEAD_DIM)
        v = p[..., 2 * ATT_WIDTH:3 * ATT_WIDTH].reshape(B, S, DA_HEADS, DA_V_DIM)
        att = diff_attention(q, k, v, da_qnorm_g[l], da_knorm_g[l], da_lambda[l], da_subln_g[l],
                             lambda_init_fn(l))
        rw = rwkv7_bidir(p[..., 3 * ATT_WIDTH:], rw_shift_mu[l], rw_w0[l], rw_w2[l], rw_a0[l], rw_a2[l],
                         rw_g2[l], rw_k_k[l], rw_k_a[l], rw_r_k[l], rw_ln_g[l], rw_ln_b[l])
        x = x + gate1 * (jnp.concatenate([att, rw], axis=-1) @ w_out[l])
        h2 = rms_norm(x, norm2_g[l]) * (1.0 + scale2) + shift2
        x = x + gate2 * peer_ffn(h2, peer_wq[l], peer_keys[l], peer_u[l], peer_v[l])
    return x
```

```cpp
#include <hip/hip_runtime.h>
#include <hip/hip_cooperative_groups.h>
#include <stdint.h>
#include <cstdio>
namespace cg = cooperative_groups;

#define DI __device__ __forceinline__
typedef unsigned short u16;
using bf16x8 = __attribute__((ext_vector_type(8))) short;
using f32x16 = __attribute__((ext_vector_type(16))) float;
typedef __bf16 bf16x2_t __attribute__((ext_vector_type(2)));
typedef float f32x2_t __attribute__((ext_vector_type(2)));
typedef unsigned u32x4 __attribute__((ext_vector_type(4)));
typedef unsigned u32x2 __attribute__((ext_vector_type(2)));
typedef float f32x4 __attribute__((ext_vector_type(4)));
#define MFMA32(a, b, c) __builtin_amdgcn_mfma_f32_32x32x16_bf16((a), (b), (c), 0, 0, 0)

constexpr int NTOK = 16384, SEQ = 2048, DM = 1024, NB = 8;
constexpr int INC = 3456, RWC = 1920;
constexpr float LOG2E = 1.4426950408889634f;

constexpr size_t OFF_BAR   = 0;
constexpr size_t OFF_MOD   = 65536;
constexpr size_t OFF_RSTD1 = OFF_MOD + 8 * 6144 * 4;
constexpr size_t OFF_SS2   = OFF_RSTD1 + 65536;
constexpr size_t OFF_SW    = OFF_SS2 + 65536;
constexpr size_t OFF_W2T   = OFF_SW + 65536;
constexpr size_t OFF_A2T   = OFF_W2T + 131072;
constexpr size_t OFF_G2T   = OFF_A2T + 131072;
constexpr size_t OFF_KEYS  = OFF_G2T + 131072;
constexpr size_t OFF_WOUTT = OFF_KEYS + 524288;
constexpr size_t OFF_WQT   = OFF_WOUTT + 2097152;
constexpr size_t OFF_WINT  = OFF_WQT + 4194304;
constexpr size_t OFF_PRW   = OFF_WINT + 7077888;
constexpr size_t SZ_PRW    = (size_t)NTOK * RWC * 2;
constexpr size_t OFF_YF    = OFF_PRW;
constexpr size_t OFF_YB    = OFF_PRW + (size_t)NTOK * 512 * 2;
constexpr size_t OFF_U8    = OFF_PRW + (size_t)NTOK * 1024 * 2;
constexpr size_t OFF_V8A   = OFF_U8 + (size_t)16384 * 1024;
constexpr int    V8_SPLIT  = 12288;
static_assert(OFF_V8A + (size_t)V8_SPLIT * 1024 <= OFF_PRW + SZ_PRW, "fp8 tables overflow");
constexpr size_t OFF_GB    = OFF_PRW + SZ_PRW;
constexpr size_t OFF_G     = OFF_GB;
constexpr size_t OFF_BONUS = OFF_GB + (size_t)NTOK * 512 * 2;
constexpr size_t OFF_X1G   = OFF_GB;
constexpr size_t OFF_R     = OFF_GB + (size_t)NTOK * 1024 * 2;
constexpr size_t OFF_RS    = OFF_R;
constexpr size_t OFF_KS    = OFF_RS + (size_t)NTOK * 512 * 2;
constexpr size_t OFF_VS    = OFF_KS + (size_t)NTOK * 512 * 2;
constexpr size_t OFF_INVN  = OFF_VS + (size_t)NTOK * 512 * 2;
constexpr size_t OFF_DEC   = OFF_INVN + (size_t)NTOK * 8 * 4;
constexpr size_t OFF_AA    = OFF_DEC + (size_t)2 * NTOK * 512 * 4;
constexpr size_t OFF_REND  = OFF_AA + (size_t)2 * NTOK * 512 * 2;
constexpr size_t OFF_V8B   = OFF_REND;
constexpr size_t OFF_USC   = OFF_V8B + (size_t)(16384 - V8_SPLIT) * 1024;
constexpr size_t OFF_VSC   = OFF_USC + 65536;
constexpr size_t OFF_SS2P  = OFF_VSC + 65536;
static_assert(OFF_SS2P + (size_t)NTOK * 8 * 4 <= 268435456ull, "workspace overflow");
constexpr size_t OFF_H1    = OFF_R;
constexpr size_t OFF_RWOUT = OFF_R;
constexpr size_t OFF_TOPK  = OFF_R;
constexpr size_t OFF_X1    = OFF_R + (size_t)NTOK * 512 * 2;
constexpr size_t OFF_Q2    = OFF_X1 + (size_t)NTOK * 1024 * 4;
constexpr size_t OFF_Q2END = OFF_Q2 + (size_t)NTOK * 2048 * 2;
static_assert(OFF_Q2END <= OFF_REND, "overlay overflow");
static_assert(OFF_REND <= 268435456ull, "workspace overflow");
constexpr size_t OUT_QK = 0;
constexpr size_t OUT_VT = (size_t)NTOK * 1024 * 2;
constexpr size_t OUT_ATT = 50331648;

#define XB_TMO      128
#define XB_XCNT(j)  (256  + 64 * (j))
#define XB_XSUB(j)  (1280 + 64 * (j))
#define XB_XGEN(j)  (2304 + 64 * (j))
#define XB_TOP      3328
#define XB_TOPGEN   3392
#define XCD_BAR_WORDS 3456
#define XB_SPIN_CAP (1u << 20)
#define LAS __attribute__((address_space(3)))

DI unsigned xb_ld(unsigned* p)              { return __hip_atomic_load(p, __ATOMIC_RELAXED, __HIP_MEMORY_SCOPE_AGENT); }
DI unsigned xb_add(unsigned* p, unsigned v) { return __hip_atomic_fetch_add(p, v, __ATOMIC_RELAXED, __HIP_MEMORY_SCOPE_AGENT); }
DI unsigned xb_xcc_id() { return (unsigned)__builtin_amdgcn_s_getreg((3 << 11) | 20) & 0xFu; }
#define XB_SPIN(cond, bar) do { unsigned _sp = 0; while (cond) { __builtin_amdgcn_s_sleep(1); \
    if ((++_sp & 255u) == 0u) { if (xb_ld(&(bar)[XB_TMO])) break; if (_sp > XB_SPIN_CAP) { atomicAdd(&(bar)[XB_TMO], 1u); break; } } } } while (0)

struct XcdBarrier { unsigned* bar; unsigned x; volatile LAS unsigned* st; };

DI XcdBarrier xcd_barrier_post(unsigned* bar, volatile LAS unsigned* st) {
    XcdBarrier b; b.bar = bar; b.x = xb_xcc_id(); b.st = st;
    if (threadIdx.x == 0) (void)xb_add(&bar[XB_XCNT(b.x)], 1u);
    return b;
}
DI void xcd_barrier_complete(unsigned* bar, unsigned x, unsigned& nloc, unsigned& nx) {
    const unsigned G = gridDim.x * gridDim.y * gridDim.z;
    unsigned sum, cnt, mine, sp = 0u;
    for (;;) {
        sum = 0u; cnt = 0u; mine = 0u;
#pragma unroll
        for (unsigned j = 0; j < 16; ++j) { const unsigned c = xb_ld(&bar[XB_XCNT(j)]); sum += c; cnt += (c > 0u) ? 1u : 0u; mine = (j == x) ? c : mine; }
        if (sum == G) break;
        __builtin_amdgcn_s_sleep(1);
        if ((++sp & 255u) == 0u) { if (xb_ld(&bar[XB_TMO])) break; if (sp > XB_SPIN_CAP) { atomicAdd(&bar[XB_TMO], 1u); break; } }
    }
    nloc = mine > 0u ? mine : 1u; nx = cnt > 0u ? cnt : 1u;
}
DI void xcd_barrier(const XcdBarrier& b) {
    asm volatile("s_waitcnt vmcnt(0)" ::: "memory");
    __syncthreads();
    if (threadIdx.x == 0) {
        unsigned* bar = b.bar;
        __builtin_amdgcn_s_waitcnt(0);
        unsigned nloc = b.st[0], nx = b.st[1];
        if (nloc == 0u) { xcd_barrier_complete(bar, b.x, nloc, nx); b.st[0] = nloc; b.st[1] = nx; }
        const unsigned old = xb_add(&bar[XB_XSUB(b.x)], 1u);
        const unsigned gen = old / nloc;
        if (old + 1u == (gen + 1u) * nloc) {
            __builtin_amdgcn_fence(__ATOMIC_RELEASE, "agent");
            asm volatile("s_waitcnt vmcnt(0)" ::: "memory");
            const unsigned og = xb_add(&bar[XB_TOP], 1u);
            const unsigned tg = og / nx;
            if (og + 1u == (tg + 1u) * nx) xb_add(&bar[XB_TOPGEN], 1u);
            else XB_SPIN(xb_ld(&bar[XB_TOPGEN]) == tg, bar);
            __builtin_amdgcn_fence(__ATOMIC_ACQUIRE, "agent");
            xb_add(&bar[XB_XGEN(b.x)], 1u);
            asm volatile("s_waitcnt vmcnt(0)" ::: "memory");
        } else {
            XB_SPIN(xb_ld(&bar[XB_XGEN(b.x)]) == gen, bar);
            __builtin_amdgcn_fence(__ATOMIC_ACQUIRE, "agent");
            asm volatile("s_waitcnt vmcnt(0)" ::: "memory");
        }
    }
    __syncthreads();
}

DI float ss2_row(const float* ss2p, int row) {
    const float4 a = *(const float4*)(ss2p + (size_t)row * 8), b = *(const float4*)(ss2p + (size_t)row * 8 + 4);
    return ((a.x + a.y) + (a.z + a.w)) + ((b.x + b.y) + (b.z + b.w));
}
DI unsigned pack2(float lo, float hi) {
    f32x2_t v = {lo, hi};
    bf16x2_t b = __builtin_convertvector(v, bf16x2_t);
    return __builtin_bit_cast(unsigned, b);
}
DI u16 f2bf(float x) { return (u16)(pack2(x, 0.f) & 0xffffu); }
DI float bf2f(u16 b) { return __uint_as_float((unsigned)b << 16); }
DI float bflo(unsigned u) { return __uint_as_float(u << 16); }
DI float bfhi(unsigned u) { return __uint_as_float(u & 0xffff0000u); }
DI int crow(int reg, int h) { return (reg & 3) + 8 * (reg >> 2) + 4 * h; }
template <int CTRL> DI float dppmov(float x) {
    return __builtin_bit_cast(float, __builtin_amdgcn_update_dpp(0, __builtin_bit_cast(int, x), CTRL, 0xf, 0xf, false));
}
template <int CTRL, int RM> DI float dppm(float x) {
    return __builtin_bit_cast(float, __builtin_amdgcn_update_dpp(0, __builtin_bit_cast(int, x), CTRL, RM, 0xf, false));
}
DI float row16_sum(float x) {
    x += dppmov<0xB1>(x);  x += dppmov<0x4E>(x);  x += dppmov<0x124>(x);  x += dppmov<0x128>(x);
    return x;
}
DI float grp8_sum(float x) { x += __shfl_xor(x, 1); x += __shfl_xor(x, 2); x += __shfl_xor(x, 4); return x; }
DI float half_sum(float x) { x = row16_sum(x); x += __shfl_xor(x, 16); return x; }
DI float wave_sum(float x) { x = half_sum(x); x += __shfl_xor(x, 32); return x; }
DI float wave_max(float x) {
    x = fmaxf(x, __shfl_xor(x, 1)); x = fmaxf(x, __shfl_xor(x, 2)); x = fmaxf(x, __shfl_xor(x, 4));
    x = fmaxf(x, __shfl_xor(x, 8)); x = fmaxf(x, __shfl_xor(x, 16)); x = fmaxf(x, __shfl_xor(x, 32)); return x;
}
DI float fma_(float a, float b, float c) { float d; asm("v_fma_f32 %0, %1, %2, %3" : "=v"(d) : "v"(a), "v"(b), "v"(c)); return d; }
DI float mul_(float a, float b) { float d; asm("v_mul_f32 %0, %1, %2" : "=v"(d) : "v"(a), "v"(b)); return d; }
DI float add_(float a, float b) { float d; asm("v_add_f32 %0, %1, %2" : "=v"(d) : "v"(a), "v"(b)); return d; }
DI float sigmoidf_(float x) { return 1.f / (1.f + __expf(-x)); }

DI void load8(const u16* ptr, float (&o)[8]) {
    const u32x4 u = *(const u32x4*)ptr;
    o[0] = bflo(u.x); o[1] = bfhi(u.x); o[2] = bflo(u.y); o[3] = bfhi(u.y); o[4] = bflo(u.z); o[5] = bfhi(u.z); o[6] = bflo(u.w); o[7] = bfhi(u.w);
}
DI void store8(u16* ptr, const float (&v)[8]) {
    u32x4 o; o.x = pack2(v[0], v[1]); o.y = pack2(v[2], v[3]); o.z = pack2(v[4], v[5]); o.w = pack2(v[6], v[7]);
    *(u32x4*)ptr = o;
}
struct Params {
    const float *x, *c, *ada_w, *ada_b, *norm1_g, *w_in, *qn_g, *kn_g, *da_lambda, *subln_g,
                *mu, *w0, *w2, *a0, *a2, *g2, *k_k, *k_a, *r_k, *ln_g, *ln_b, *w_out, *norm2_g,
                *wq, *keys, *U, *V;
    float* out; unsigned char* ws;
};

DI void transpose_convert(const float* __restrict__ src, u16* __restrict__ dst, int R, int C, float* tile, int bid, int nb) {
    const int tid = threadIdx.x;
    const int tr_n = R / 64, tc_n = C / 64;
    for (int it = bid; it < tr_n * tc_n; it += nb) {
        const int tr = it / tc_n, tc = it % tc_n;
        __syncthreads();
#pragma unroll
        for (int i = 0; i < 4; ++i) {
            const int r = (tid >> 4) + 16 * i, c4 = tid & 15;
            const f32x4 v = *(const f32x4*)(src + (size_t)(64 * tr + r) * C + 64 * tc + 4 * c4);
            tile[r * 65 + 4 * c4 + 0] = v.x; tile[r * 65 + 4 * c4 + 1] = v.y; tile[r * 65 + 4 * c4 + 2] = v.z; tile[r * 65 + 4 * c4 + 3] = v.w;
        }
        __syncthreads();
#pragma unroll
        for (int i = 0; i < 2; ++i) {
            const int c = (tid >> 3) + 32 * i, r8 = (tid & 7) * 8;
            u32x4 o;
            o.x = pack2(tile[(r8 + 0) * 65 + c], tile[(r8 + 1) * 65 + c]);
            o.y = pack2(tile[(r8 + 2) * 65 + c], tile[(r8 + 3) * 65 + c]);
            o.z = pack2(tile[(r8 + 4) * 65 + c], tile[(r8 + 5) * 65 + c]);
            o.w = pack2(tile[(r8 + 6) * 65 + c], tile[(r8 + 7) * 65 + c]);
            *(u32x4*)(dst + (size_t)(64 * tc + c) * R + 64 * tr + r8) = o;
        }
    }
    __syncthreads();
}
DI void convert_bf16(const float* __restrict__ src, u16* __restrict__ dst, size_t n, int bid, int nb) {
    const size_t n8 = n / 8;
    for (size_t i = (size_t)bid * 256 + threadIdx.x; i < n8; i += (size_t)nb * 256) {
        const f32x4 a = *(const f32x4*)(src + i * 8), b = *(const f32x4*)(src + i * 8 + 4);
        u32x4 o; o.x = pack2(a.x, a.y); o.y = pack2(a.z, a.w); o.z = pack2(b.x, b.y); o.w = pack2(b.z, b.w);
        *(u32x4*)(dst + i * 8) = o;
    }
}

DI void ph0(const Params& p, char* smem, int bid, int nb) {
    const int tid = threadIdx.x, lane = tid & 63, wave = tid >> 6;
    {
        float* sc = (float*)smem;
        float* red = sc + 8 * 1024;
        float* mod = (float*)(p.ws + OFF_MOD);
        bool loaded = false;
        for (int it = bid; it < 96; it += nb) {
            if (!loaded) {
                for (int i = tid; i < 8 * 1024; i += 256) { const float v = p.c[i]; sc[i] = v / (1.f + __expf(-v)); }
                loaded = true;
            }
            __syncthreads();
            const int col = tid & 63, kq = tid >> 6;
            float acc[8];
#pragma unroll
            for (int b = 0; b < 8; ++b) acc[b] = 0.f;
            for (int k = kq * 256; k < kq * 256 + 256; ++k) {
                const float w = p.ada_w[(size_t)k * 6144 + 64 * it + col];
#pragma unroll
                for (int b = 0; b < 8; ++b) acc[b] += sc[b * 1024 + k] * w;
            }
#pragma unroll
            for (int b = 0; b < 8; ++b) red[(kq * 8 + b) * 64 + col] = acc[b];
            __syncthreads();
            for (int e = tid; e < 512; e += 256) {
                const int b = e >> 6, cc = e & 63;
                const float v = red[(0 * 8 + b) * 64 + cc] + red[(1 * 8 + b) * 64 + cc] + red[(2 * 8 + b) * 64 + cc] + red[(3 * 8 + b) * 64 + cc];
                mod[b * 6144 + 64 * it + cc] = v + p.ada_b[64 * it + cc];
            }
        }
        __syncthreads();
    }
    float* tile = (float*)smem;
    transpose_convert(p.w_in, (u16*)(p.ws + OFF_WINT), 1024, INC, tile, bid, nb);
    transpose_convert(p.w_out, (u16*)(p.ws + OFF_WOUTT), 1024, 1024, tile, bid, nb);
    transpose_convert(p.wq, (u16*)(p.ws + OFF_WQT), 1024, 2048, tile, bid, nb);
    for (int d = 0; d < 2; ++d) {
        transpose_convert(p.w2 + (size_t)d * 64 * 512, (u16*)(p.ws + OFF_W2T) + (size_t)d * 512 * 64, 64, 512, tile, bid, nb);
        transpose_convert(p.a2 + (size_t)d * 64 * 512, (u16*)(p.ws + OFF_A2T) + (size_t)d * 512 * 64, 64, 512, tile, bid, nb);
    }
    transpose_convert(p.g2, (u16*)(p.ws + OFF_G2T), 128, 512, tile, bid, nb);
    convert_bf16(p.keys, (u16*)(p.ws + OFF_KEYS), (size_t)16 * 128 * 128, bid, nb);
}

constexpr int LDT = 72;
constexpr int GEMM_SMEM = 2 * 128 * LDT * 2;

DI void gemm_compute_tile(f32x16 (&acc)[2][2], const u16* As, const u16* Bs, int wr, int wc, int r, int h) {
#pragma unroll
    for (int ks = 0; ks < 4; ++ks) {
        const bf16x8 a0 = *(const bf16x8*)(As + (wr * 64 + r) * LDT + ks * 16 + 8 * h);
        const bf16x8 a1 = *(const bf16x8*)(As + (wr * 64 + 32 + r) * LDT + ks * 16 + 8 * h);
        const bf16x8 b0 = *(const bf16x8*)(Bs + (wc * 64 + r) * LDT + ks * 16 + 8 * h);
        const bf16x8 b1 = *(const bf16x8*)(Bs + (wc * 64 + 32 + r) * LDT + ks * 16 + 8 * h);
        acc[0][0] = MFMA32(a0, b0, acc[0][0]);
        acc[0][1] = MFMA32(a0, b1, acc[0][1]);
        acc[1][0] = MFMA32(a1, b0, acc[1][0]);
        acc[1][1] = MFMA32(a1, b1, acc[1][1]);
    }
}

DI bool xcd_tile(int bid, int nb, int rnd, int NT, int& mt, int& nt) {
    if (nb & 7) { const int it = bid + rnd * nb; if (it >= 128 * NT) return false; mt = it / NT; nt = it - mt * NT; return true; }
    const int x = bid & 7, j = bid >> 3, per = nb >> 3;
    const int t = rnd * per + j;
    if (t >= 16 * NT) return false;
    const int half = (t >= 8 * NT) ? 1 : 0, u = t - half * 8 * NT;
    nt = u >> 3; mt = x * 16 + half * 8 + (u & 7);
    return true;
}
constexpr int GEMM_STAGE = 2 * 128 * LDT;
DI void gemm_bf16A(f32x16 (&acc)[2][2], const u16* __restrict__ A, int lda, const u16* __restrict__ Bt, int ldb, int nk, char* smem) {
    u16* S0 = (u16*)smem;
    const int tid = threadIdx.x, lane = tid & 63, wave = tid >> 6;
    const int wr = wave >> 1, wc = wave & 1, r = lane & 31, h = lane >> 5;
    const int kc = tid & 7, r0 = tid >> 3;
    u32x4 ar[4], br[4];
    const u16* ap = A + (size_t)r0 * lda + 8 * kc; const u16* bp = Bt + (size_t)r0 * ldb + 8 * kc;
#define GEMM_LOAD(KT) _Pragma("unroll") for (int i = 0; i < 4; ++i) { \
        ar[i] = *(const u32x4*)(ap + (size_t)(32 * i) * lda + 64 * (KT)); br[i] = *(const u32x4*)(bp + (size_t)(32 * i) * ldb + 64 * (KT)); }
#define GEMM_STORE(BUF) _Pragma("unroll") for (int i = 0; i < 4; ++i) { \
        *(u32x4*)(S0 + (BUF) * GEMM_STAGE + (r0 + 32 * i) * LDT + 8 * kc) = ar[i]; \
        *(u32x4*)(S0 + (BUF) * GEMM_STAGE + 128 * LDT + (r0 + 32 * i) * LDT + 8 * kc) = br[i]; }
    GEMM_LOAD(0)
    __syncthreads();
    GEMM_STORE(0)
    if (nk > 1) { GEMM_LOAD(1) }
#pragma unroll 1
    for (int kt = 0; kt < nk; ++kt) {
        __syncthreads();
        const int cur = kt & 1;
        if (kt + 1 < nk) { GEMM_STORE(cur ^ 1) }
        if (kt + 2 < nk) { GEMM_LOAD(kt + 2) }
        gemm_compute_tile(acc, S0 + cur * GEMM_STAGE, S0 + cur * GEMM_STAGE + 128 * LDT, wr, wc, r, h);
    }
}

constexpr int LDT2 = 136;
DI void gemm_bf16A_k128(f32x16 (&acc)[2][2], const u16* __restrict__ A, int lda, const u16* __restrict__ Bt, int ldb, int nk, char* smem) {
    u16* As = (u16*)smem; u16* Bs = As + 128 * LDT2;
    const int tid = threadIdx.x, lane = tid & 63, wave = tid >> 6;
    const int wr = wave >> 1, wc = wave & 1, r = lane & 31, h = lane >> 5;
    const int kc = tid & 15, r0 = tid >> 4;
    u32x4 ar[8], br[8];
    const u16* ap = A + (size_t)r0 * lda + 8 * kc; const u16* bp = Bt + (size_t)r0 * ldb + 8 * kc;
#pragma unroll
    for (int i = 0; i < 8; ++i) { ar[i] = *(const u32x4*)(ap + (size_t)(16 * i) * lda); br[i] = *(const u32x4*)(bp + (size_t)(16 * i) * ldb); }
#pragma unroll 1
    for (int kt = 0; kt < nk; ++kt) {
        __syncthreads();
#pragma unroll
        for (int i = 0; i < 8; ++i) {
            *(u32x4*)(As + (r0 + 16 * i) * LDT2 + 8 * kc) = ar[i];
            *(u32x4*)(Bs + (r0 + 16 * i) * LDT2 + 8 * kc) = br[i];
        }
        __syncthreads();
        if (kt + 1 < nk) {
#pragma unroll
            for (int i = 0; i < 8; ++i) {
                ar[i] = *(const u32x4*)(ap + (size_t)(16 * i) * lda + 128 * (kt + 1));
                br[i] = *(const u32x4*)(bp + (size_t)(16 * i) * ldb + 128 * (kt + 1));
            }
        }
#pragma unroll
        for (int ks = 0; ks < 8; ++ks) {
            const bf16x8 a0 = *(const bf16x8*)(As + (wr * 64 + r) * LDT2 + ks * 16 + 8 * h);
            const bf16x8 a1 = *(const bf16x8*)(As + (wr * 64 + 32 + r) * LDT2 + ks * 16 + 8 * h);
            const bf16x8 b0 = *(const bf16x8*)(Bs + (wc * 64 + r) * LDT2 + ks * 16 + 8 * h);
            const bf16x8 b1 = *(const bf16x8*)(Bs + (wc * 64 + 32 + r) * LDT2 + ks * 16 + 8 * h);
            acc[0][0] = MFMA32(a0, b0, acc[0][0]); acc[0][1] = MFMA32(a0, b1, acc[0][1]);
            acc[1][0] = MFMA32(a1, b0, acc[1][0]); acc[1][1] = MFMA32(a1, b1, acc[1][1]);
        }
    }
}
DI void gemm_bf16A_256(f32x16 (&acc)[2][2][2], const u16* __restrict__ A, int lda, const u16* __restrict__ Bt, int ldb, int nk, char* smem) {
    u16* As = (u16*)smem; u16* Bs = As + 256 * LDT;
    const int tid = threadIdx.x, lane = tid & 63, wave = tid >> 6;
    const int wr = wave >> 1, wc = wave & 1, r = lane & 31, h = lane >> 5;
    const int kc = tid & 7, r0 = tid >> 3;
    u32x4 ar[8], br[4];
    const u16* ap = A + (size_t)r0 * lda + 8 * kc; const u16* bp = Bt + (size_t)r0 * ldb + 8 * kc;
#pragma unroll
    for (int i = 0; i < 8; ++i) ar[i] = *(const u32x4*)(ap + (size_t)(32 * i) * lda);
#pragma unroll
    for (int i = 0; i < 4; ++i) br[i] = *(const u32x4*)(bp + (size_t)(32 * i) * ldb);
#pragma unroll 1
    for (int kt = 0; kt < nk; ++kt) {
        __syncthreads();
#pragma unroll
        for (int i = 0; i < 8; ++i) *(u32x4*)(As + (r0 + 32 * i) * LDT + 8 * kc) = ar[i];
#pragma unroll
        for (int i = 0; i < 4; ++i) *(u32x4*)(Bs + (r0 + 32 * i) * LDT + 8 * kc) = br[i];
        __syncthreads();
        if (kt + 1 < nk) {
#pragma unroll
            for (int i = 0; i < 8; ++i) ar[i] = *(const u32x4*)(ap + (size_t)(32 * i) * lda + 64 * (kt + 1));
#pragma unroll
            for (int i = 0; i < 4; ++i) br[i] = *(const u32x4*)(bp + (size_t)(32 * i) * ldb + 64 * (kt + 1));
        }
#pragma unroll
        for (int ks = 0; ks < 4; ++ks) {
            const bf16x8 b0 = *(const bf16x8*)(Bs + (wc * 64 + r) * LDT + ks * 16 + 8 * h);
            const bf16x8 b1 = *(const bf16x8*)(Bs + (wc * 64 + 32 + r) * LDT + ks * 16 + 8 * h);
#pragma unroll
            for (int hf = 0; hf < 2; ++hf) {
                const bf16x8 a0 = *(const bf16x8*)(As + (hf * 128 + wr * 64 + r) * LDT + ks * 16 + 8 * h);
                const bf16x8 a1 = *(const bf16x8*)(As + (hf * 128 + wr * 64 + 32 + r) * LDT + ks * 16 + 8 * h);
                acc[hf][0][0] = MFMA32(a0, b0, acc[hf][0][0]); acc[hf][0][1] = MFMA32(a0, b1, acc[hf][0][1]);
                acc[hf][1][0] = MFMA32(a1, b0, acc[hf][1][0]); acc[hf][1][1] = MFMA32(a1, b1, acc[hf][1][1]);
            }
        }
    }
}
DI bool xcd_tile256(int bid, int nb, int rnd, int NT, int& mt, int& nt) {
    if (nb & 7) { const int it = bid + rnd * nb; if (it >= 64 * NT) return false; mt = it / NT; nt = it - mt * NT; return true; }
    const int x = bid & 7, j = bid >> 3, per = nb >> 3;
    const int t = rnd * per + j;
    if (t >= 8 * NT) return false;
    nt = t >> 3; mt = x * 8 + (t & 7);
    return true;
}
DI void gemm_f32A(f32x16 (&acc)[2][2], const float* __restrict__ X, const float (&rs)[8], const float* __restrict__ g,
                  const float* __restrict__ scale, const float* __restrict__ shift, const u16* __restrict__ Bt, char* smem) {
    u16* As = (u16*)smem; u16* Bs = As + 128 * LDT;
    const int tid = threadIdx.x, lane = tid & 63, wave = tid >> 6;
    const int wr = wave >> 1, wc = wave & 1, r = lane & 31, h = lane >> 5;
    const int kcA = tid & 15, rA = tid >> 4;
    const int kc = tid & 7, r0 = tid >> 3;
    f32x4 xr[8]; u32x4 br[4]; f32x4 gm, sh;
#pragma unroll
    for (int i = 0; i < 8; ++i) xr[i] = *(const f32x4*)(X + (size_t)(rA + 16 * i) * DM + 4 * kcA);
#pragma unroll
    for (int i = 0; i < 4; ++i) br[i] = *(const u32x4*)(Bt + (size_t)(r0 + 32 * i) * DM + 8 * kc);
    {
        const f32x4 gg = *(const f32x4*)(g + 4 * kcA), ss = *(const f32x4*)(scale + 4 * kcA);
        sh = *(const f32x4*)(shift + 4 * kcA);
        gm.x = gg.x * (1.f + ss.x); gm.y = gg.y * (1.f + ss.y); gm.z = gg.z * (1.f + ss.z); gm.w = gg.w * (1.f + ss.w);
    }
    for (int kt = 0; kt < 16; ++kt) {
        __syncthreads();
#pragma unroll
        for (int i = 0; i < 8; ++i) {
            const float s = rs[i];
            u32x2 o;
            o.x = pack2(xr[i].x * s * gm.x + sh.x, xr[i].y * s * gm.y + sh.y);
            o.y = pack2(xr[i].z * s * gm.z + sh.z, xr[i].w * s * gm.w + sh.w);
            *(u32x2*)(As + (rA + 16 * i) * LDT + 4 * kcA) = o;
        }
#pragma unroll
        for (int i = 0; i < 4; ++i) *(u32x4*)(Bs + (r0 + 32 * i) * LDT + 8 * kc) = br[i];
        __syncthreads();
        if (kt + 1 < 16) {
            const int k0 = 64 * (kt + 1);
#pragma unroll
            for (int i = 0; i < 8; ++i) xr[i] = *(const f32x4*)(X + (size_t)(rA + 16 * i) * DM + k0 + 4 * kcA);
#pragma unroll
            for (int i = 0; i < 4; ++i) br[i] = *(const u32x4*)(Bt + (size_t)(r0 + 32 * i) * DM + k0 + 8 * kc);
            const f32x4 gg = *(const f32x4*)(g + k0 + 4 * kcA), ss = *(const f32x4*)(scale + k0 + 4 * kcA);
            sh = *(const f32x4*)(shift + k0 + 4 * kcA);
            gm.x = gg.x * (1.f + ss.x); gm.y = gg.y * (1.f + ss.y); gm.z = gg.z * (1.f + ss.z); gm.w = gg.w * (1.f + ss.w);
        }
        gemm_compute_tile(acc, As, Bs, wr, wc, r, h);
    }
}
DI void zero_acc(f32x16 (&acc)[2][2]) {
#pragma unroll
    for (int a = 0; a < 2; ++a)
#pragma unroll
        for (int b = 0; b < 2; ++b)
#pragma unroll
            for (int i = 0; i < 16; ++i) acc[a][b][i] = 0.f;
}


constexpr int LDO = 136;
DI float half_total(float x, int h) {
    x = row16_sum(x);
    x += dppm<0x142, 0xa>(x);
    const float s0 = __builtin_bit_cast(float, __builtin_amdgcn_readlane(__builtin_bit_cast(int, x), 31));
    const float s1 = __builtin_bit_cast(float, __builtin_amdgcn_readlane(__builtin_bit_cast(int, x), 63));
    return h ? s1 : s0;
}
template <bool TRANSPOSE> DI void stage_tile_bf16(u16* Os, const f32x16 (&acc)[2][2], int wr, int wc, int r, int h) {
#pragma unroll
    for (int mi = 0; mi < 2; ++mi)
#pragma unroll
        for (int ni = 0; ni < 2; ++ni)
#pragma unroll
            for (int i = 0; i < 16; ++i) {
                const int row = wr * 64 + mi * 32 + (i & 3) + 8 * (i >> 2) + 4 * h, col = wc * 64 + ni * 32 + r;
                Os[TRANSPOSE ? (col * LDO + row) : (row * LDO + col)] = f2bf(acc[mi][ni][i]);
            }
}
DI void flush_tile_bf16(const u16* Os, u16* __restrict__ dst, size_t ld) {
    const int tid = threadIdx.x;
#pragma unroll
    for (int j = 0; j < 8; ++j) {
        const int id = tid + 256 * j, row = id >> 4, c16 = id & 15;
        const u32x4 v = *(const u32x4*)(Os + row * LDO + c16 * 8);
        *(u32x4*)(dst + (size_t)row * ld + c16 * 8) = v;
    }
}

DI void ph1a(const Params& p, int bid, int nb) {
    const int tid = threadIdx.x, lane = tid & 63, wave = tid >> 6;
    const float* mod = (const float*)(p.ws + OFF_MOD);
    u16* H1 = (u16*)(p.ws + OFF_H1);
    f32x4 nx[4];
    {
        const int row0 = bid * 4 + wave;
        if (row0 < NTOK) {
            const f32x4* xr = (const f32x4*)(p.x + (size_t)row0 * DM + 16 * lane);
#pragma unroll
            for (int q = 0; q < 4; ++q) nx[q] = xr[q];
        }
    }
    for (int row = bid * 4 + wave; row < NTOK; row += nb * 4) {
        const int b = row / SEQ;
        const f32x4* gp = (const f32x4*)(p.norm1_g + 16 * lane);
        const f32x4* scp = (const f32x4*)(mod + b * 6144 + 1024 + 16 * lane);
        const f32x4* shp = (const f32x4*)(mod + b * 6144 + 16 * lane);
        f32x4 xv[4];
        float ss = 0.f;
#pragma unroll
        for (int q = 0; q < 4; ++q) { xv[q] = nx[q]; ss += xv[q].x * xv[q].x + xv[q].y * xv[q].y + xv[q].z * xv[q].z + xv[q].w * xv[q].w; }
        if (row + nb * 4 < NTOK) {
            const f32x4* xr = (const f32x4*)(p.x + (size_t)(row + nb * 4) * DM + 16 * lane);
#pragma unroll
            for (int q = 0; q < 4; ++q) nx[q] = xr[q];
        }
        ss = wave_sum(ss);
        const float rs = rsqrtf(ss * (1.f / 1024.f) + 1e-6f);
        unsigned o[8];
#pragma unroll
        for (int q = 0; q < 4; ++q) {
            const f32x4 g = gp[q], sc = scp[q], sh = shp[q];
            o[2 * q]     = pack2(xv[q].x * rs * g.x * (1.f + sc.x) + sh.x, xv[q].y * rs * g.y * (1.f + sc.y) + sh.y);
            o[2 * q + 1] = pack2(xv[q].z * rs * g.z * (1.f + sc.z) + sh.z, xv[q].w * rs * g.w * (1.f + sc.w) + sh.w);
        }
        u32x4* dst = (u32x4*)(H1 + (size_t)row * DM + 16 * lane);
        dst[0] = (u32x4){o[0], o[1], o[2], o[3]}; dst[1] = (u32x4){o[4], o[5], o[6], o[7]};
    }
    const u16* WQT = (const u16*)(p.ws + OFF_WQT);
    float* SW = (float*)(p.ws + OFF_SW);
    for (int n = bid * 4 + wave; n < 2048; n += nb * 4) {
        float w[16];
        load8(WQT + (size_t)n * DM + 16 * lane, *(float(*)[8])&w[0]);
        load8(WQT + (size_t)n * DM + 16 * lane + 8, *(float(*)[8])&w[8]);
#pragma unroll 1
        for (int b = 0; b < 8; ++b) {
            const f32x4* shp = (const f32x4*)(mod + b * 6144 + 3072 + 16 * lane);
            float sacc = 0.f;
#pragma unroll
            for (int q = 0; q < 4; ++q) { const f32x4 sh = shp[q]; sacc += sh.x * w[4 * q] + sh.y * w[4 * q + 1] + sh.z * w[4 * q + 2] + sh.w * w[4 * q + 3]; }
            sacc = wave_sum(sacc);
            if (lane == 0) SW[b * 2048 + n] = sacc;
        }
    }
}

DI void ph1(const Params& p, char* smem, int bid, int nb) {
    const int tid = threadIdx.x, lane = tid & 63, wave = tid >> 6;
    const int wr = wave >> 1, wc = wave & 1, r = lane & 31, h = lane >> 5;
    const u16* H1 = (const u16*)(p.ws + OFF_H1);
    const u16* WT = (const u16*)(p.ws + OFF_WINT);
    u16* QK = (u16*)((char*)p.out + OUT_QK); u16* VT = (u16*)((char*)p.out + OUT_VT);
    u16* PRW = (u16*)(p.ws + OFF_PRW);
    int mt, nt;
    for (int rnd = 0; xcd_tile(bid, nb, rnd, 27, mt, nt); ++rnd) {
        const int m0 = mt * 128, n0 = nt * 128, b = m0 / SEQ;
        f32x16 acc[2][2]; zero_acc(acc);
        gemm_bf16A_k128(acc, H1 + (size_t)m0 * DM, DM, WT + (size_t)n0 * DM, DM, 8, smem);
        u16* Os = (u16*)smem;
        if (nt < 8) {
            const float* gv = (nt < 4) ? p.qn_g : p.kn_g;
            const float mul = (nt < 4) ? 0.125f * LOG2E : 1.f;
            const float g0 = gv[r] * mul, g1 = gv[32 + r] * mul;
#pragma unroll
            for (int mi = 0; mi < 2; ++mi)
#pragma unroll
                for (int i = 0; i < 16; ++i) {
                    const float v0 = acc[mi][0][i], v1 = acc[mi][1][i];
                    const float ss = half_total(v0 * v0 + v1 * v1, h);
                    const float rn = rsqrtf(ss * (1.f / 64.f) + 1e-6f);
                    acc[mi][0][i] = v0 * rn * g0; acc[mi][1][i] = v1 * rn * g1;
                }
        }
        __syncthreads();
        if (nt >= 8 && nt < 12) stage_tile_bf16<true>(Os, acc, wr, wc, r, h);
        else stage_tile_bf16<false>(Os, acc, wr, wc, r, h);
        __syncthreads();
        if (nt < 8) flush_tile_bf16(Os, QK + (size_t)m0 * 1024 + n0, 1024);
        else if (nt < 12) flush_tile_bf16(Os, VT + ((size_t)(b * 4 + (nt - 8)) * 128) * SEQ + (m0 % SEQ), SEQ);
        else flush_tile_bf16(Os, PRW + (size_t)m0 * RWC + (n0 - 1536), RWC);
    }
}

DI void shifted8(const u16* PRW, const float* mu, int tok, int c, float (&o)[8]) {
    const int t = tok % SEQ;
    float cur[8], prv[8], nxt[8];
    load8(PRW + (size_t)tok * RWC + c, cur);
    if (t > 0) load8(PRW + (size_t)(tok - 1) * RWC + c, prv); else {
#pragma unroll
        for (int j = 0; j < 8; ++j) prv[j] = 0.f; }
    if (t < SEQ - 1) load8(PRW + (size_t)(tok + 1) * RWC + c, nxt); else {
#pragma unroll
        for (int j = 0; j < 8; ++j) nxt[j] = 0.f; }
    const f32x4 m0a = *(const f32x4*)(mu + c), m0b = *(const f32x4*)(mu + c + 4);
    const f32x4 m1a = *(const f32x4*)(mu + RWC + c), m1b = *(const f32x4*)(mu + RWC + c + 4);
    const float m0[8] = {m0a.x, m0a.y, m0a.z, m0a.w, m0b.x, m0b.y, m0b.z, m0b.w};
    const float m1[8] = {m1a.x, m1a.y, m1a.z, m1a.w, m1b.x, m1b.y, m1b.z, m1b.w};
#pragma unroll
    for (int j = 0; j < 8; ++j) o[j] = cur[j] + m0[j] * (prv[j] - cur[j]) + m1[j] * (nxt[j] - cur[j]);
}
DI void shifted8c(const u16* PRW, const float (&m0)[8], const float (&m1)[8], int tok, int c, float (&o)[8]) {
    const int t = tok % SEQ;
    float cur[8], prv[8], nxt[8];
    load8(PRW + (size_t)tok * RWC + c, cur);
    if (t > 0) load8(PRW + (size_t)(tok - 1) * RWC + c, prv); else {
#pragma unroll
        for (int j = 0; j < 8; ++j) prv[j] = 0.f; }
    if (t < SEQ - 1) load8(PRW + (size_t)(tok + 1) * RWC + c, nxt); else {
#pragma unroll
        for (int j = 0; j < 8; ++j) nxt[j] = 0.f; }
#pragma unroll
    for (int j = 0; j < 8; ++j) o[j] = cur[j] + m0[j] * (prv[j] - cur[j]) + m1[j] * (nxt[j] - cur[j]);
}
DI void load8f(const float* ptr, float (&o)[8]) {
    const f32x4 a = *(const f32x4*)ptr, b = *(const f32x4*)(ptr + 4);
    o[0] = a.x; o[1] = a.y; o[2] = a.z; o[3] = a.w; o[4] = b.x; o[5] = b.y; o[6] = b.z; o[7] = b.w;
}
DI void ph2a(const Params& p, int bid, int nb) {
    const u16* PRW = (const u16*)(p.ws + OFF_PRW);
    u16* RS = (u16*)(p.ws + OFF_RS); u16* KS = (u16*)(p.ws + OFF_KS); u16* VS = (u16*)(p.ws + OFF_VS);
    u16* BON = (u16*)(p.ws + OFF_BONUS); float* INVN = (float*)(p.ws + OFF_INVN);
    const int c = (threadIdx.x & 63) * 8, hd = c >> 6;
    float mr0[8], mr1[8], mk0[8], mk1[8], mv0[8], mv1[8], kkv[8], rkv[8];
    load8f(p.mu + c, mr0); load8f(p.mu + RWC + c, mr1);
    load8f(p.mu + 512 + c, mk0); load8f(p.mu + RWC + 512 + c, mk1);
    load8f(p.mu + 1024 + c, mv0); load8f(p.mu + RWC + 1024 + c, mv1);
    load8f(p.k_k + c, kkv); load8f(p.r_k + c, rkv);
    for (int e = bid * 256 + threadIdx.x; e < NTOK * 64; e += nb * 256) {
        const int tok = e >> 6;
        float rr[8], kk[8], vv[8];
        shifted8c(PRW, mr0, mr1, tok, c, rr);
        shifted8c(PRW, mk0, mk1, tok, 512 + c, kk);
        shifted8c(PRW, mv0, mv1, tok, 1024 + c, vv);
        float ssq = 0.f, rkr = 0.f;
#pragma unroll
        for (int j = 0; j < 8; ++j) { const float t = kk[j] * kkv[j]; ssq += t * t; rkr += rr[j] * kk[j] * rkv[j]; }
        ssq = grp8_sum(ssq); rkr = grp8_sum(rkr);
        store8(RS + (size_t)tok * 512 + c, rr); store8(KS + (size_t)tok * 512 + c, kk); store8(VS + (size_t)tok * 512 + c, vv);
        float bo[8];
#pragma unroll
        for (int j = 0; j < 8; ++j) bo[j] = rkr * vv[j];
        store8(BON + (size_t)tok * 512 + c, bo);
        if ((e & 7) == 0) INVN[tok * 8 + hd] = 1.f / fmaxf(sqrtf(ssq), 1e-12f);
    }
}

constexpr int LDP = 136;
DI void ph2b(const Params& p, char* smem, int bid, int nb) {
    const int tid = threadIdx.x, lane = tid & 63, wave = tid >> 6, r = lane & 31, h = lane >> 5;
    u16* TW = (u16*)smem; u16* AD = TW + 32 * LDP; u16* SG = AD + 32 * LDP;
    const u16* PRW = (const u16*)(p.ws + OFF_PRW);
    const u16* W2T = (const u16*)(p.ws + OFF_W2T); const u16* A2T = (const u16*)(p.ws + OFF_A2T); const u16* G2T = (const u16*)(p.ws + OFF_G2T);
    u16* DEC = (u16*)(p.ws + OFF_DEC); u16* AA = (u16*)(p.ws + OFF_AA); u16* G = (u16*)(p.ws + OFF_G);
    for (int it = bid; it < NTOK / 32; it += nb) {
        const int tok0 = it * 32;
        __syncthreads();
        for (int e = tid; e < 32 * 48; e += 256) {
            const int tl = e / 48, c8 = (e % 48) * 8;
            float v[8];
            shifted8(PRW, p.mu, tok0 + tl, 1536 + c8, v);
            if (c8 < 128) {
#pragma unroll
                for (int j = 0; j < 8; ++j) v[j] = tanhf(v[j]);
                store8(TW + tl * LDP + c8, v);
            } else if (c8 < 256) {
                store8(AD + tl * LDP + (c8 - 128), v);
            } else {
#pragma unroll
                for (int j = 0; j < 8; ++j) v[j] = sigmoidf_(v[j]);
                store8(SG + tl * LDP + (c8 - 256), v);
            }
        }
        __syncthreads();
        bf16x8 bcur[8], bnxt[8];
#define P2_LOADB(DST, IT) { const int g_ = (IT) >> 2, n_ = wave * 128 + ((IT) & 3) * 32 + r, d_ = g_ & 1; \
            const u16* bs_ = (g_ < 2) ? W2T + (size_t)d_ * 512 * 64 : (g_ < 4 ? A2T + (size_t)d_ * 512 * 64 : G2T); \
            const int ldb_ = (g_ < 4) ? 64 : 128; \
            _Pragma("unroll") for (int ks = 0; ks < 4; ++ks) DST[ks] = *(const bf16x8*)(bs_ + (size_t)n_ * ldb_ + ks * 16 + 8 * h); \
            if (g_ == 4) { _Pragma("unroll") for (int ks = 4; ks < 8; ++ks) DST[ks] = *(const bf16x8*)(bs_ + (size_t)n_ * ldb_ + ks * 16 + 8 * h); } }
        P2_LOADB(bcur, 0)
#pragma unroll 1
        for (int it = 0; it < 20; ++it) {
            const int gsel = it >> 2, ni = it & 3, dir = gsel & 1;
            const u16* Asrc = (gsel < 2) ? TW : (gsel < 4 ? AD : SG);
            const int acol = (gsel < 4) ? dir * 64 : 0;
            const int n = wave * 128 + ni * 32 + r;
            if (it + 1 < 20) P2_LOADB(bnxt, it + 1)
            f32x16 acc0;
#pragma unroll
            for (int i = 0; i < 16; ++i) acc0[i] = 0.f;
#pragma unroll
            for (int ks = 0; ks < 4; ++ks) {
                const bf16x8 a0 = *(const bf16x8*)(Asrc + r * LDP + acol + ks * 16 + 8 * h);
                acc0 = MFMA32(a0, bcur[ks], acc0);
            }
            if (gsel == 4) {
#pragma unroll
                for (int ks = 4; ks < 8; ++ks) {
                    const bf16x8 a0 = *(const bf16x8*)(Asrc + r * LDP + acol + ks * 16 + 8 * h);
                    acc0 = MFMA32(a0, bcur[ks], acc0);
                }
            }
            if (gsel < 2) {
                const float w0v = p.w0[dir * 512 + n];
#pragma unroll
                for (int i = 0; i < 16; ++i) {
                    const float pre = w0v + acc0[i];
                    const float z = -pre;
                    const float sp = fmaxf(z, 0.f) + __logf(1.f + __expf(-fabsf(z)));
                    const float w = -sp - 0.5f;
                    const float dec = __expf(-__expf(w));
                    DEC[((size_t)dir * NTOK + tok0 + crow(i, h)) * 512 + n] = f2bf(1.f - dec);
                }
            } else if (gsel < 4) {
                const float a0v = p.a0[dir * 512 + n];
#pragma unroll
                for (int i = 0; i < 16; ++i) {
                    const float a = sigmoidf_(a0v + acc0[i]);
                    AA[((size_t)dir * NTOK + tok0 + crow(i, h)) * 512 + n] = f2bf(a);
                }
            } else {
#pragma unroll
                for (int i = 0; i < 16; ++i)
                    G[(size_t)(tok0 + crow(i, h)) * 512 + n] = f2bf(acc0[i]);
            }
#pragma unroll
            for (int ks = 0; ks < 8; ++ks) bcur[ks] = bnxt[ks];
        }
    }
}

constexpr int LDK = 136, LDV = 68, ATT_STAGE = 64 * LDK + 128 * LDV;
DI void ph2c(const Params& p, char* smem, int bid, int nb) {
    const int tid = threadIdx.x, lane = tid & 63, wave = tid >> 6, r = lane & 31, h = lane >> 5;
    const int qg = wave >> 1, c = wave & 1;
    u16* Kt = (u16*)smem; u16* Vs = Kt + 64 * LDK;
    float* exch = (float*)smem;
    u16* QK = (u16*)((char*)p.out + OUT_QK); const u16* VT = (const u16*)((char*)p.out + OUT_VT);
    float lam, M2;
    {
        const float l0 = p.da_lambda[lane], l1 = p.da_lambda[64 + lane], l2 = p.da_lambda[128 + lane], l3 = p.da_lambda[192 + lane];
        const float s1 = wave_sum(l0 * l1), s2 = wave_sum(l2 * l3);
        lam = __expf(s1) - __expf(s2) + 0.2f;
        const float mq = wave_max(fabsf(p.qn_g[lane])), mk = wave_max(fabsf(p.kn_g[lane]));
        M2 = 8.f * mq * mk * LOG2E;
    }
    for (int it = bid; it < NB * 4 * 32; it += nb) {
        const int qt = it & 31, hd = (it >> 5) & 3, b = it >> 7;
        const int q0 = qt * 64 + qg * 32;
        const float slope2 = exp2f(-2.f * (hd + 1)) * LOG2E;
        bf16x8 qfr[4];
        {
            const u16* qp = QK + (size_t)(b * SEQ + q0 + r) * 1024 + hd * 128 + c * 64 + 8 * h;
#pragma unroll
            for (int ks = 0; ks < 4; ++ks) qfr[ks] = *(const bf16x8*)(qp + ks * 16);
        }
        const u16* kg = QK + (size_t)(b * SEQ) * 1024 + 512 + hd * 128;
        const u16* vg = VT + (size_t)(b * 4 + hd) * 128 * SEQ;
        u32x4 kreg[4], vreg[4];
        const unsigned koff = (unsigned)((tid >> 4) * 2048 + (tid & 15) * 16), voff = (unsigned)((tid >> 3) * (SEQ * 2) + (tid & 7) * 16);
#define ATT_LOAD(KT) { const char* kb_ = (const char*)(kg + (size_t)(KT) * 64 * 1024); const char* vb_ = (const char*)(vg + (KT) * 64); \
            _Pragma("unroll") for (int j = 0; j < 4; ++j) { \
            kreg[j] = *(const u32x4*)(kb_ + (koff + (unsigned)j * 32768u)); \
            vreg[j] = *(const u32x4*)(vb_ + (voff + (unsigned)j * (32u * SEQ * 2u))); } }
#define ATT_STORE(BUF) _Pragma("unroll") for (int j = 0; j < 4; ++j) { const int id = tid + 256 * j; \
            *(u32x4*)(Kt + (BUF) * ATT_STAGE + (id >> 4) * LDK + (id & 15) * 8) = kreg[j]; \
            u32x2* d = (u32x2*)(Vs + (BUF) * ATT_STAGE + (id >> 3) * LDV + (id & 7) * 8); \
            d[0] = (u32x2){vreg[j].x, vreg[j].y}; d[1] = (u32x2){vreg[j].z, vreg[j].w}; }
        ATT_LOAD(0)
        __syncthreads();
        ATT_STORE(0)
        ATT_LOAD(1)
        f32x16 O[4];
#pragma unroll
        for (int dt = 0; dt < 4; ++dt)
#pragma unroll
            for (int i = 0; i < 16; ++i) O[dt][i] = 0.f;
        float lsum = 0.f;
#pragma unroll 1
        for (int kt = 0; kt < SEQ / 64; ++kt) {
            __syncthreads();
            const int cur = kt & 1;
            if (kt + 1 < SEQ / 64) { ATT_STORE(cur ^ 1) }
            if (kt + 2 < SEQ / 64) { ATT_LOAD(kt + 2) }
            const u16* Kc = Kt + cur * ATT_STAGE; const u16* Vc = Vs + cur * ATT_STAGE;
#pragma unroll
            for (int sub = 0; sub < 2; ++sub) {
                const int k0 = kt * 64 + sub * 32;
                const float fd0 = (float)(q0 + r - (k0 + 4 * h));
                const bool diag = (k0 == q0 - (q0 & 31));
                const float ss = (q0 > k0) ? slope2 : -slope2;
                f32x16 S;
                if (diag) {
#pragma unroll
                    for (int i = 0; i < 16; ++i) S[i] = -M2;
                } else {
                    const float A = __builtin_fmaf(-ss, fd0, -M2);
#pragma unroll
                    for (int i = 0; i < 16; ++i) S[i] = __builtin_fmaf(ss, (float)((i & 3) + 8 * (i >> 2)), A);
                }
#pragma unroll
                for (int ks = 0; ks < 4; ++ks) {
                    const bf16x8 kf = *(const bf16x8*)(Kc + (sub * 32 + r) * LDK + c * 64 + ks * 16 + 8 * h);
                    S = MFMA32(kf, qfr[ks], S);
                }
                float pv[16];
                if (diag) {
#pragma unroll
                    for (int i = 0; i < 16; ++i) {
                        const float t = fd0 - (float)((i & 3) + 8 * (i >> 2));
                        pv[i] = __builtin_amdgcn_exp2f(S[i] - slope2 * fabsf(t));
                    }
                } else {
#pragma unroll
                    for (int i = 0; i < 16; ++i) pv[i] = __builtin_amdgcn_exp2f(S[i]);
                }
#pragma unroll
                for (int i = 0; i < 16; ++i) lsum += pv[i];
                bf16x8 pa[2];
#pragma unroll
                for (int s = 0; s < 2; ++s) {
                    u32x4 cv;
#pragma unroll
                    for (int j = 0; j < 4; ++j) cv[j] = pack2(pv[8 * s + 2 * j], pv[8 * s + 2 * j + 1]);
                    pa[s] = __builtin_bit_cast(bf16x8, cv);
                }
#pragma unroll
                for (int s = 0; s < 2; ++s)
#pragma unroll
                    for (int dt = 0; dt < 4; ++dt) {
                        const u16* vp = Vc + (dt * 32 + r) * LDV + sub * 32 + 16 * s + 4 * h;
                        const u32x2 vlo = *(const u32x2*)(vp), vhi = *(const u32x2*)(vp + 8);
                        const bf16x8 vb = __builtin_bit_cast(bf16x8, (u32x4){vlo.x, vlo.y, vhi.x, vhi.y});
                        O[dt] = MFMA32(pa[s], vb, O[dt]);
                    }
            }
        }
        lsum += __shfl_xor(lsum, 32);
        const float il = (c == 0) ? 1.f / lsum : lam / lsum;
#pragma unroll
        for (int i = 0; i < 16; ++i) {
            const float a = __shfl(il, crow(i, h));
#pragma unroll
            for (int dt = 0; dt < 4; ++dt) O[dt][i] *= a;
        }
        __syncthreads();
        if (c == 1) {
#pragma unroll
            for (int dt = 0; dt < 4; ++dt)
#pragma unroll
                for (int i = 0; i < 16; ++i) exch[((qg * 4 + dt) * 16 + i) * 64 + lane] = O[dt][i];
        }
        __syncthreads();
        if (c == 0) {
            float gsub[4];
#pragma unroll
            for (int dt = 0; dt < 4; ++dt) gsub[dt] = p.subln_g[dt * 32 + r] * 0.8f;
#pragma unroll
            for (int i = 0; i < 16; ++i) {
                float o[4], ss = 0.f;
#pragma unroll
                for (int dt = 0; dt < 4; ++dt) { o[dt] = O[dt][i] - exch[((qg * 4 + dt) * 16 + i) * 64 + lane]; ss += o[dt] * o[dt]; }
                ss = half_sum(ss);
                const float rn = rsqrtf(ss * (1.f / 128.f) + 1e-6f);
                u16* dst = (u16*)((char*)p.out + OUT_ATT) + (size_t)(b * SEQ + q0 + crow(i, h)) * 512 + hd * 128 + r;
#pragma unroll
                for (int dt = 0; dt < 4; ++dt) dst[dt * 32] = f2bf(o[dt] * rn * gsub[dt]);
            }
        }
    }
}

struct ScanBuf { float kk[16][64], dec[16][64], bb[16][64], kd[16][64], rr[16][64], vv[16][16]; };
struct ScanRegs { u32x2 rs, ks, aa; f32x4 dec; float invn; u16 v; };
DI void scan_load(ScanRegs& g, const Params& p, int b, int hd, int dir, int rg, int chunk) {
    const int tid = threadIdx.x, s = tid >> 4, kq = tid & 15;
    const int t = dir ? (SEQ - 1 - (chunk * 16 + s)) : (chunk * 16 + s);
    const size_t tok = (size_t)b * SEQ + t;
    const size_t off = tok * 512 + hd * 64 + 4 * kq;
    g.rs = *(const u32x2*)((const u16*)(p.ws + OFF_RS) + off);
    g.ks = *(const u32x2*)((const u16*)(p.ws + OFF_KS) + off);
    g.aa = *(const u32x2*)((const u16*)(p.ws + OFF_AA) + (size_t)dir * NTOK * 512 + off);
    g.dec = *(const f32x4*)((const float*)(p.ws + OFF_DEC) + (size_t)dir * NTOK * 512 + off);
    g.invn = ((const float*)(p.ws + OFF_INVN))[tok * 8 + hd];
    g.v = ((const u16*)(p.ws + OFF_VS))[tok * 512 + hd * 64 + rg * 16 + kq];
}
DI void scan_store(const ScanRegs& g, ScanBuf* sb, const f32x4& kkc, const f32x4& kac) {
    const int tid = threadIdx.x, s = tid >> 4, kq = tid & 15;
    const float k0 = bflo(g.ks.x), k1 = bfhi(g.ks.x), k2 = bflo(g.ks.y), k3 = bfhi(g.ks.y);
    const float a0 = bflo(g.aa.x), a1 = bfhi(g.aa.x), a2 = bflo(g.aa.y), a3 = bfhi(g.aa.y);
    f32x4 kk, bb, kd, rr;
    kk.x = k0 * kkc.x * g.invn; kk.y = k1 * kkc.y * g.invn; kk.z = k2 * kkc.z * g.invn; kk.w = k3 * kkc.w * g.invn;
    bb.x = kk.x * a0; bb.y = kk.y * a1; bb.z = kk.z * a2; bb.w = kk.w * a3;
    kd.x = k0 * (1.f + (a0 - 1.f) * kac.x); kd.y = k1 * (1.f + (a1 - 1.f) * kac.y);
    kd.z = k2 * (1.f + (a2 - 1.f) * kac.z); kd.w = k3 * (1.f + (a3 - 1.f) * kac.w);
    rr.x = bflo(g.rs.x); rr.y = bfhi(g.rs.x); rr.z = bflo(g.rs.y); rr.w = bfhi(g.rs.y);
    *(f32x4*)&sb->kk[s][4 * kq] = kk; *(f32x4*)&sb->dec[s][4 * kq] = g.dec; *(f32x4*)&sb->bb[s][4 * kq] = bb;
    *(f32x4*)&sb->kd[s][4 * kq] = kd; *(f32x4*)&sb->rr[s][4 * kq] = rr;
    sb->vv[s][kq] = bf2f(g.v);
}
DI void ph3(const Params& p, char* smem, int bid, int nb) {
    const int tid = threadIdx.x, lane = tid & 63, wave = tid >> 6;
    ScanBuf* sb = (ScanBuf*)smem;
    const int rl = lane >> 4, kq = lane & 15, row = wave * 4 + rl;
    for (int it = bid; it < 512; it += nb) {
        const int rg = it & 3, chain = it >> 2, dir = chain & 1, hd = (chain >> 1) & 7, b = chain >> 4;
        const int ld_kq = tid & 15;
        const f32x4 kkc = *(const f32x4*)(p.k_k + hd * 64 + 4 * ld_kq), kac = *(const f32x4*)(p.k_a + hd * 64 + 4 * ld_kq);
        u16* Y = (u16*)(p.ws + (dir ? OFF_YB : OFF_YF));
        f32x4 st = {0.f, 0.f, 0.f, 0.f};
        ScanRegs g;
        __syncthreads();
        scan_load(g, p, b, hd, dir, rg, 0);
        scan_store(g, &sb[0], kkc, kac);
        __syncthreads();
        for (int ch = 0; ch < SEQ / 16; ++ch) {
            const ScanBuf* cur = &sb[ch & 1];
            if (ch + 1 < SEQ / 16) scan_load(g, p, b, hd, dir, rg, ch + 1);
            float ykeep = 0.f;
#pragma unroll
            for (int s = 0; s < 16; ++s) {
                const f32x4 kk = *(const f32x4*)&cur->kk[s][4 * kq];
                const f32x4 dc = *(const f32x4*)&cur->dec[s][4 * kq];
                const f32x4 bb = *(const f32x4*)&cur->bb[s][4 * kq];
                const f32x4 kd = *(const f32x4*)&cur->kd[s][4 * kq];
                const f32x4 rr = *(const f32x4*)&cur->rr[s][4 * kq];
                const float v = cur->vv[s][row];
                float yp = 0.f;
                if (dir) yp = add_(fma_(st.x, rr.x, mul_(st.y, rr.y)), fma_(st.z, rr.z, mul_(st.w, rr.w)));
                const float sa = -row16_sum(add_(fma_(st.x, kk.x, mul_(st.y, kk.y)), fma_(st.z, kk.z, mul_(st.w, kk.w))));
                st.x = fma_(sa, bb.x, fma_(st.x, dc.x, mul_(v, kd.x)));
                st.y = fma_(sa, bb.y, fma_(st.y, dc.y, mul_(v, kd.y)));
                st.z = fma_(sa, bb.z, fma_(st.z, dc.z, mul_(v, kd.z)));
                st.w = fma_(sa, bb.w, fma_(st.w, dc.w, mul_(v, kd.w)));
                if (!dir) yp = add_(fma_(st.x, rr.x, mul_(st.y, rr.y)), fma_(st.z, rr.z, mul_(st.w, rr.w)));
                const float y = row16_sum(yp);
                ykeep = (kq == s) ? y : ykeep;
            }
            if (ch + 1 < SEQ / 16) scan_store(g, &sb[(ch + 1) & 1], kkc, kac);
            {
                const int t = dir ? (SEQ - 1 - (ch * 16 + kq)) : (ch * 16 + kq);
                Y[((size_t)b * SEQ + t) * 512 + hd * 64 + rg * 16 + row] = f2bf(ykeep);
            }
            __syncthreads();
        }
    }
}

constexpr int C4_A1 = 0, C4_A1SZ = 5632;
constexpr int C4_SETB = 16896, C4_SETBSZ = 8448;
constexpr int C4_VT = 5120, C4_G16 = 8192;
constexpr int C4_LK = 50688, C4_LR = 55296, C4_LKSZ = 2304;
constexpr int C4_LBKR = 62208, C4_LBKRSZ = 4608;
constexpr int C4_M4 = 71424, C4_M4SZ = 4096;
constexpr int C4_TOTAL = 79616;
typedef int i32x4_t __attribute__((ext_vector_type(4)));
#define C4_COEF(V4, S, T) __builtin_bit_cast(float, __builtin_amdgcn_readlane(V4[(T) & 3], 4 * (S) + ((T) >> 2)))
#define C4_MU(T) (((T) & 3) + 8 * (((T) >> 2) & 1) + 4 * ((T) >> 3))
struct C4Raw { unsigned ks[16], rs[16], vs[16], aa[16], dc[16]; int inv; };
DI void c4_load_step(C4Raw& w, const Params& p, int dir, unsigned tokb, unsigned lane2, int j) {
    const char* RS = (const char*)(p.ws + OFF_RS); const char* KS = (const char*)(p.ws + OFF_KS); const char* VS = (const char*)(p.ws + OFF_VS);
    const char* AA = (const char*)(p.ws + OFF_AA + (size_t)dir * NTOK * 512 * 2);
    const char* DEC = (const char*)(p.ws + OFF_DEC + (size_t)dir * NTOK * 512 * 2);
    const unsigned o2 = tokb + lane2;
    w.ks[j] = *(const u16*)(KS + o2); w.rs[j] = *(const u16*)(RS + o2); w.vs[j] = *(const u16*)(VS + o2); w.aa[j] = *(const u16*)(AA + o2);
    w.dc[j] = *(const u16*)(DEC + o2);
}
DI unsigned c4_tokb0(int b, int hd, int dir, int c1) {
    return (unsigned)(b * SEQ + (dir ? (SEQ - 1 - 16 * c1) : 16 * c1)) * 1024u + (unsigned)(hd * 128);
}
DI int c4_load_inv(const Params& p, int b, int hd, int dir, int c1, int lane) {
    const int* INVN = (const int*)(p.ws + OFF_INVN);
    const int st = 16 * c1 + (lane & 15);
    const unsigned tok = (unsigned)(b * SEQ + (dir ? (SEQ - 1 - st) : st));
    return INVN[tok * 8u + (unsigned)hd];
}
DI void c4_x(C4Raw& w, const Params& p, char* smem, int cx, int b, int hd, int dir, int lane, float kkc, float kac) {
    asm volatile("" : "+v"(lane));
    u16* LK = (u16*)(smem + C4_LK + (cx & 1) * C4_LKSZ); u16* LR = (u16*)(smem + C4_LR + (cx % 3) * C4_LKSZ);
    u16* LBKR = (u16*)(smem + C4_LBKR + (cx & 1) * C4_LBKRSZ);
    char* setb = smem + C4_SETB + (cx & 3) * C4_SETBSZ;
    u16* LBKT = (u16*)setb; u16* VT = (u16*)(setb + C4_VT); float* G16 = (float*)(setb + C4_G16);
    const int cn = (cx + 1 < SEQ / 16) ? cx + 1 : cx;
    const int invv = w.inv;
    const int inv_next = c4_load_inv(p, b, hd, dir, cn, lane);
    const unsigned lane2 = 2u * (unsigned)lane;
    unsigned tb = c4_tokb0(b, hd, dir, cn);
    const unsigned tstep = dir ? (unsigned)-1024 : 1024u;
    float G = 1.f;
#pragma unroll
    for (int j = 0; j < 16; j += 2) {
        float nb_[2], kd_[2];
#pragma unroll
        for (int e = 0; e < 2; ++e) {
            const int s = j + e;
            asm volatile("" : "+v"(w.ks[s]), "+v"(w.aa[s]), "+v"(w.rs[s]), "+v"(w.vs[s]), "+v"(w.dc[s]) : "v"(G));
            const float kf = __uint_as_float(w.ks[s] << 16), af = __uint_as_float(w.aa[s] << 16), rf = __uint_as_float(w.rs[s] << 16);
            const float inv = __builtin_bit_cast(float, __builtin_amdgcn_readlane(invv, s));
            const float kkv = kf * kkc * inv;
            const float bbv = kkv * af;
            const float kdv = kf * __builtin_fmaf(af, kac, 1.f - kac);
            const float kt = kkv * G;
            const float Gb = G;
            G *= 1.f - __uint_as_float(w.dc[s] << 16);
            const float rsel = rf * (dir ? Gb : G);
            const float ig = __builtin_amdgcn_rcpf(G);
            float ig2 = ig; asm volatile("" : "+v"(ig2));
            const float bt = bbv * ig, kdt = kdv * ig2;
            const unsigned pkr = pack2(kt, rsel), pbk = pack2(bt, kdt);
            LK[s * 72 + lane] = (u16)pkr;
            LR[s * 72 + lane] = (u16)(pkr >> 16);
            LBKR[s * 72 + lane] = (u16)pbk;
            LBKR[(16 + s) * 72 + lane] = (u16)(pbk >> 16);
            nb_[e] = -bt; kd_[e] = kdt;
        }
        *(unsigned*)(LBKT + lane * 40 + j) = pack2(nb_[0], nb_[1]);
        *(unsigned*)(LBKT + lane * 40 + 16 + j) = pack2(kd_[0], kd_[1]);
        *(unsigned*)(VT + lane * 24 + j) = w.vs[j] | (w.vs[j + 1] << 16);
        c4_load_step(w, p, dir, tb, lane2, j); tb += tstep;
        c4_load_step(w, p, dir, tb, lane2, j + 1); tb += tstep;
    }
    G16[lane] = G;
    w.inv = inv_next;
}
DI void c4_y(char* smem, int cy, int dir, int lane) {
    asm volatile("" : "+v"(lane));
    const u16* LK = (const u16*)(smem + C4_LK + (cy & 1) * C4_LKSZ); const u16* LR = (const u16*)(smem + C4_LR + (cy % 3) * C4_LKSZ);
    const u16* LBKR = (const u16*)(smem + C4_LBKR + (cy & 1) * C4_LBKRSZ);
    float* M4 = (float*)(smem + C4_M4 + (cy & 1) * C4_M4SZ);
    u16* A1 = (u16*)(smem + C4_A1 + (cy % 3) * C4_A1SZ);
    const int r = lane & 31, h = lane >> 5;
    {
        f32x16 acc;
#pragma unroll
        for (int i = 0; i < 16; ++i) acc[i] = 0.f;
        const u16* brow = (r < 16) ? (LK + r * 72) : (LR + (r - 16) * 72);
#pragma unroll
        for (int ks = 0; ks < 4; ++ks) {
            const bf16x8 a = *(const bf16x8*)(LBKR + r * 72 + ks * 16 + 8 * h);
            const bf16x8 bq = *(const bf16x8*)(brow + ks * 16 + 8 * h);
            acc = MFMA32(a, bq, acc);
        }
        const int t = r & 15, lim = t + (((r >> 4) & (dir ^ 1)));
        float* dst = M4 + (r >> 4) * 256 + t + 4 * h * 16;
#pragma unroll
        for (int i = 0; i < 16; ++i) {
            const int s0 = (i & 3) + 8 * ((i >> 2) & 1);
            dst[(i >> 3) * 512 + s0 * 16] = (s0 + 4 * h < lim) ? acc[i] : 0.f;
        }
    }
    __builtin_amdgcn_s_waitcnt(0xc07f); asm volatile("" ::: "memory");
    f32x2_t kp[16];
#pragma unroll
    for (int t = 0; t < 16; ++t) kp[t].x = bf2f(LK[t * 72 + lane]);
#pragma unroll
    for (int q = 0; q < 4; ++q) {
        const f32x4 m = *(const f32x4*)(M4 + 512 + (lane & 15) * 16 + 4 * q);
        kp[4 * q].y = m.x; kp[4 * q + 1].y = m.y; kp[4 * q + 2].y = m.z; kp[4 * q + 3].y = m.w;
    }
    {
        f32x4 cf[2][4];
#pragma unroll
        for (int q = 0; q < 4; ++q) cf[0][q] = *(const f32x4*)(M4 + 4 * q);
#pragma unroll
        for (int s2 = 0; s2 < 15; ++s2) {
            if (s2 + 1 < 15) {
                int off = 0; asm volatile("" : "+v"(off) : "v"(kp[s2].x));
                const float* rowp = M4 + off + (s2 + 1) * 16;
#pragma unroll
                for (int q = (s2 + 2) >> 2; q < 4; ++q) cf[(s2 + 1) & 1][q] = *(const f32x4*)(rowp + 4 * q);
            }
            const f32x2_t sp = kp[s2];
#pragma unroll
            for (int t = s2 + 1; t < 16; ++t) {
                const float c = -cf[s2 & 1][t >> 2][t & 3];
                kp[t] = __builtin_elementwise_fma((f32x2_t){c, c}, sp, kp[t]);
            }
        }
    }
    const int pos = (lane & 0x30) | ((lane & 4) << 1) | ((lane & 8) >> 1) | (lane & 3);
    u16* A1p = A1 + 64 + (lane & 15);
    if (lane >= 16) A1p = A1 + 80 + (lane & 7);
#pragma unroll
    for (int t = 0; t < 16; ++t) {
        const unsigned pk = pack2(kp[t].x, kp[t].y);
        A1[C4_MU(t) * 88 + pos] = (u16)pk; A1p[C4_MU(t) * 88] = (u16)(pk >> 16);
    }
}
DI void c4_z(char* smem, int cz, int lane) {
    asm volatile("" : "+v"(lane));
    const u16* LR = (const u16*)(smem + C4_LR + (cz % 3) * C4_LKSZ);
    const float* M4 = (const float*)(smem + C4_M4 + (cz & 1) * C4_M4SZ);
    u16* A1 = (u16*)(smem + C4_A1 + (cz % 3) * C4_A1SZ);
    const int pos = (lane & 0x30) | ((lane & 4) << 1) | ((lane & 8) >> 1) | (lane & 3);
    f32x2_t kp[16], rq[16];
#pragma unroll
    for (int t = 0; t < 16; ++t) {
        kp[t].x = bf2f(A1[C4_MU(t) * 88 + pos]); kp[t].y = bf2f(A1[C4_MU(t) * 88 + 64 + (lane & 15)]);
        rq[t].x = bf2f(LR[t * 72 + lane]);
    }
#pragma unroll
    for (int q = 0; q < 4; ++q) {
        const f32x4 m = *(const f32x4*)(M4 + 768 + (lane & 15) * 16 + 4 * q);
        rq[4 * q].y = m.x; rq[4 * q + 1].y = m.y; rq[4 * q + 2].y = m.z; rq[4 * q + 3].y = m.w;
    }
    {
        f32x4 cf[2][4];
#pragma unroll
        for (int q = 0; q < 4; ++q) cf[0][q] = *(const f32x4*)(M4 + 256 + 4 * q);
#pragma unroll
        for (int s2 = 0; s2 < 16; ++s2) {
            if (s2 + 1 < 16) {
                int off = 0; asm volatile("" : "+v"(off) : "v"(rq[s2].x));
                const float* rowp = M4 + 256 + off + (s2 + 1) * 16;
#pragma unroll
                for (int q = (s2 + 1) >> 2; q < 4; ++q) cf[(s2 + 1) & 1][q] = *(const f32x4*)(rowp + 4 * q);
            }
#pragma unroll
            for (int t = s2; t < 16; ++t) {
                const float c = -cf[s2 & 1][t >> 2][t & 3];
                rq[t] = __builtin_elementwise_fma((f32x2_t){c, c}, kp[s2], rq[t]);
            }
        }
    }
    u16* A1p = A1 + 64 + (lane & 15);
    if (lane >= 16) A1p = A1 + 80 + (lane & 7);
#pragma unroll
    for (int t = 0; t < 16; ++t) {
        const unsigned pk = pack2(rq[t].x, rq[t].y);
        A1[(16 + C4_MU(t)) * 88 + pos] = (u16)pk; A1p[(16 + C4_MU(t)) * 88] = (u16)(pk >> 16);
    }
}
#define C4_PACKB(S, SP) __builtin_bit_cast(bf16x8, (u32x4){pack2(S[8 * (SP)], S[8 * (SP) + 1]), pack2(S[8 * (SP) + 2], S[8 * (SP) + 3]), \
                                                             pack2(S[8 * (SP) + 4], S[8 * (SP) + 5]), pack2(S[8 * (SP) + 6], S[8 * (SP) + 7])})
DI void ph3c_chain(const Params& p, char* smem, int chain) {
    const int tid = threadIdx.x, lane = tid & 63, wave = __builtin_amdgcn_readfirstlane(tid >> 6);
    const int dir = chain & 1, hd = (chain >> 1) & 7, b = chain >> 4;
    constexpr int NCH = SEQ / 16;
    __syncthreads();
    if (wave == 1) {
        C4Raw raw;
#pragma unroll
        for (int j = 0; j < 16; ++j) c4_load_step(raw, p, dir, c4_tokb0(b, hd, dir, 0) + (unsigned)j * (dir ? (unsigned)-1024 : 1024u), 2u * (unsigned)lane, j);
        raw.inv = c4_load_inv(p, b, hd, dir, 0, lane);
        const float kkc = p.k_k[hd * 64 + lane], kac = p.k_a[hd * 64 + lane];
        __builtin_amdgcn_s_waitcnt(0x0f70);
#pragma unroll 1
        for (int i = -3; i < NCH; ++i) {
            if (i + 3 < NCH) c4_x(raw, p, smem, i + 3, b, hd, dir, lane, kkc, kac);
            __syncthreads();
        }
    } else if (wave == 2) {
#pragma unroll 1
        for (int i = -3; i < NCH; ++i) {
            if (i + 2 >= 0 && i + 2 < NCH) c4_y(smem, i + 2, dir, lane);
            __syncthreads();
        }
    } else if (wave == 3) {
#pragma unroll 1
        for (int i = -3; i < NCH; ++i) {
            if (i + 1 >= 0 && i + 1 < NCH) c4_z(smem, i + 1, lane);
            __syncthreads();
        }
    } else {
        __syncthreads(); __syncthreads(); __syncthreads();
        f32x16 s00, s01, s10, s11;
#pragma unroll
        for (int i = 0; i < 16; ++i) { s00[i] = 0.f; s01[i] = 0.f; s10[i] = 0.f; s11[i] = 0.f; }
        u16* Y = (u16*)(p.ws + OFF_YF);
        const int r_ = lane & 31, h_ = lane >> 5;
#pragma unroll 1
        for (int c = 0; c < NCH; ++c) {
            int cc = c; asm volatile("" : "+s"(cc));
            int r = r_, h = h_; asm volatile("" : "+v"(r), "+v"(h));
            const u16* A1 = (const u16*)(smem + C4_A1 + (cc % 3) * C4_A1SZ);
            const char* setb = smem + C4_SETB + (cc & 3) * C4_SETBSZ;
            const u16* LBKT = (const u16*)setb; const u16* VT = (const u16*)(setb + C4_VT); const float* G16 = (const float*)(setb + C4_G16);
            const bf16x8 aq0 = *(const bf16x8*)(A1 + r * 88 + 8 * h), aq1 = *(const bf16x8*)(A1 + r * 88 + 16 + 8 * h);
            const bf16x8 aq2 = *(const bf16x8*)(A1 + r * 88 + 32 + 8 * h), aq3 = *(const bf16x8*)(A1 + r * 88 + 48 + 8 * h);
            const bf16x8 ap = *(const bf16x8*)(A1 + r * 88 + 64 + 8 * h);
            const bf16x8 vb0 = *(const bf16x8*)(VT + r * 24 + 8 * h), vb1 = *(const bf16x8*)(VT + (32 + r) * 24 + 8 * h);
            f32x16 xy0, xy1;
#pragma unroll
            for (int i = 0; i < 16; ++i) { xy0[i] = 0.f; xy1[i] = 0.f; }
            xy0 = MFMA32(aq0, C4_PACKB(s00, 0), xy0); xy1 = MFMA32(aq0, C4_PACKB(s01, 0), xy1);
            xy0 = MFMA32(aq1, C4_PACKB(s00, 1), xy0); xy1 = MFMA32(aq1, C4_PACKB(s01, 1), xy1);
            xy0 = MFMA32(aq2, C4_PACKB(s10, 0), xy0); xy1 = MFMA32(aq2, C4_PACKB(s11, 0), xy1);
            xy0 = MFMA32(aq3, C4_PACKB(s10, 1), xy0); xy1 = MFMA32(aq3, C4_PACKB(s11, 1), xy1);
            xy0 = MFMA32(ap, vb0, xy0); xy1 = MFMA32(ap, vb1, xy1);
            const bf16x8 ub0 = C4_PACKB(xy0, 0), ub1 = C4_PACKB(xy1, 0);
            {
                const bf16x8 l00 = *(const bf16x8*)(LBKT + r * 40 + 8 * h), l01 = *(const bf16x8*)(LBKT + r * 40 + 16 + 8 * h);
                const bf16x8 l10 = *(const bf16x8*)(LBKT + (32 + r) * 40 + 8 * h), l11 = *(const bf16x8*)(LBKT + (32 + r) * 40 + 16 + 8 * h);
                s00 = MFMA32(l00, ub0, s00); s01 = MFMA32(l00, ub1, s01); s10 = MFMA32(l10, ub0, s10); s11 = MFMA32(l10, ub1, s11);
                s00 = MFMA32(l01, vb0, s00); s01 = MFMA32(l01, vb1, s01); s10 = MFMA32(l11, vb0, s10); s11 = MFMA32(l11, vb1, s11);
            }
            {
                const unsigned vst = (unsigned)(dir * NTOK * 512 + hd * 64 + r);
#pragma unroll
                for (int j = 0; j < 8; ++j) {
                    const int stp = 16 * cc + 8 * h + j;
                    const unsigned tok = (unsigned)(b * SEQ + (dir ? (SEQ - 1 - stp) : stp));
                    Y[tok * 512u + vst] = f2bf(xy0[8 + j]);
                    Y[tok * 512u + vst + 32u] = f2bf(xy1[8 + j]);
                }
            }
#pragma unroll
            for (int g4 = 0; g4 < 4; ++g4) {
                const f32x4 ga = *(const f32x4*)(G16 + 8 * g4 + 4 * h), gb = *(const f32x4*)(G16 + 32 + 8 * g4 + 4 * h);
                s00[4 * g4 + 0] *= ga.x; s00[4 * g4 + 1] *= ga.y; s00[4 * g4 + 2] *= ga.z; s00[4 * g4 + 3] *= ga.w;
                s01[4 * g4 + 0] *= ga.x; s01[4 * g4 + 1] *= ga.y; s01[4 * g4 + 2] *= ga.z; s01[4 * g4 + 3] *= ga.w;
                s10[4 * g4 + 0] *= gb.x; s10[4 * g4 + 1] *= gb.y; s10[4 * g4 + 2] *= gb.z; s10[4 * g4 + 3] *= gb.w;
                s11[4 * g4 + 0] *= gb.x; s11[4 * g4 + 1] *= gb.y; s11[4 * g4 + 2] *= gb.z; s11[4 * g4 + 3] *= gb.w;
            }
            __syncthreads();
        }
    }
}

DI void ph4(const Params& p, int bid, int nb) {
    const u16* YF = (const u16*)(p.ws + OFF_YF); const u16* YB = (const u16*)(p.ws + OFF_YB);
    const u16* G = (const u16*)(p.ws + OFF_G); const u16* BON = (const u16*)(p.ws + OFF_BONUS);
    u16* RWOUT = (u16*)(p.ws + OFF_RWOUT);
#pragma unroll 2
    for (int e = bid * 256 + threadIdx.x; e < NTOK * 64; e += nb * 256) {
        const int tok = e >> 6, c = (e & 63) * 8;
        float yf[8], yb[8], g[8], bo[8], y[8];
        load8(YF + (size_t)tok * 512 + c, yf); load8(YB + (size_t)tok * 512 + c, yb);
        load8(G + (size_t)tok * 512 + c, g); load8(BON + (size_t)tok * 512 + c, bo);
        float s = 0.f;
#pragma unroll
        for (int j = 0; j < 8; ++j) { y[j] = yf[j] + yb[j]; s += y[j]; }
        const float mean = grp8_sum(s) * (1.f / 64.f);
        float vs = 0.f;
#pragma unroll
        for (int j = 0; j < 8; ++j) { const float d = y[j] - mean; vs += d * d; }
        const float var = grp8_sum(vs) * (1.f / 64.f);
        const float rn = rsqrtf(var + 64e-5f);
        const f32x4 ga = *(const f32x4*)(p.ln_g + c), gb = *(const f32x4*)(p.ln_g + c + 4);
        const f32x4 ba = *(const f32x4*)(p.ln_b + c), bb = *(const f32x4*)(p.ln_b + c + 4);
        const float lg[8] = {ga.x, ga.y, ga.z, ga.w, gb.x, gb.y, gb.z, gb.w};
        const float lb[8] = {ba.x, ba.y, ba.z, ba.w, bb.x, bb.y, bb.z, bb.w};
        float o[8];
#pragma unroll
        for (int j = 0; j < 8; ++j) o[j] = ((y[j] - mean) * rn * lg[j] + lb[j] + bo[j]) * g[j];
        store8(RWOUT + (size_t)tok * 512 + c, o);
    }
}


DI unsigned pk4_fp8(float a, float b, float c, float d) {
    int w = 0;
    w = __builtin_amdgcn_cvt_pk_fp8_f32(a, b, w, false);
    w = __builtin_amdgcn_cvt_pk_fp8_f32(c, d, w, true);
    return (unsigned)w;
}
DI void convert_fp8_rows(const float* __restrict__ src, unsigned char* __restrict__ dst, unsigned char* __restrict__ dst2, int split, float* __restrict__ scales, int bid, int nb) {
    const int lane = threadIdx.x & 63, wave = threadIdx.x >> 6;
    for (int row = bid * 4 + wave; row < 16384; row += nb * 4) {
        const f32x4* sp = (const f32x4*)(src + (size_t)row * 1024 + 16 * lane);
        const f32x4 v0 = sp[0], v1 = sp[1], v2 = sp[2], v3 = sp[3];
        float m = fmaxf(fmaxf(fabsf(v0.x), fabsf(v0.y)), fmaxf(fabsf(v0.z), fabsf(v0.w)));
        m = fmaxf(m, fmaxf(fmaxf(fabsf(v1.x), fabsf(v1.y)), fmaxf(fabsf(v1.z), fabsf(v1.w))));
        m = fmaxf(m, fmaxf(fmaxf(fabsf(v2.x), fabsf(v2.y)), fmaxf(fabsf(v2.z), fabsf(v2.w))));
        m = fmaxf(m, fmaxf(fmaxf(fabsf(v3.x), fabsf(v3.y)), fmaxf(fabsf(v3.z), fabsf(v3.w))));
        m = wave_max(m);
        const float scale = (m > 0.f) ? m * (1.f / 440.f) : 1.f;
        const float inv = 1.f / scale;
        u32x4 o;
        o.x = pk4_fp8(v0.x * inv, v0.y * inv, v0.z * inv, v0.w * inv);
        o.y = pk4_fp8(v1.x * inv, v1.y * inv, v1.z * inv, v1.w * inv);
        o.z = pk4_fp8(v2.x * inv, v2.y * inv, v2.z * inv, v2.w * inv);
        o.w = pk4_fp8(v3.x * inv, v3.y * inv, v3.z * inv, v3.w * inv);
        *(u32x4*)((row < split ? dst + (size_t)row * 1024 : dst2 + (size_t)(row - split) * 1024) + 16 * lane) = o;
        if (lane == 0) scales[row] = scale;
    }
}

DI void ph5(const Params& p, char* smem, int bid, int nb) {
    const int tid = threadIdx.x, lane = tid & 63, wave = tid >> 6;
    const int wr = wave >> 1, wc = wave & 1, r = lane & 31, h = lane >> 5;
    const u16* ATT = (const u16*)((char*)p.out + OUT_ATT);
    const u16* RWOUT = (const u16*)(p.ws + OFF_RWOUT);
    const u16* WT = (const u16*)(p.ws + OFF_WOUTT);
    const float* mod = (const float*)(p.ws + OFF_MOD);
    float* X1 = (float*)(p.ws + OFF_X1); float* ss2p = (float*)(p.ws + OFF_SS2P);
    u16* X1G = (u16*)(p.ws + OFF_X1G);
    int mt, nt;
    for (int rnd = 0; xcd_tile256(bid, nb, rnd, 8, mt, nt); ++rnd) {
      const int n0 = nt * 128;
      f32x16 accs[2][2][2];
#pragma unroll
      for (int hf = 0; hf < 2; ++hf) zero_acc(accs[hf]);
      gemm_bf16A_256(accs, ATT + (size_t)(mt * 256) * 512, 512, WT + (size_t)n0 * 1024, 1024, 8, smem);
      gemm_bf16A_256(accs, RWOUT + (size_t)(mt * 256) * 512, 512, WT + (size_t)n0 * 1024 + 512, 1024, 8, smem);
#pragma unroll
      for (int hf = 0; hf < 2; ++hf) {
        f32x16 (&acc)[2][2] = accs[hf];
        const int m0 = mt * 256 + hf * 128, b = m0 / SEQ;
        const float* gate = mod + b * 6144 + 2048 + n0;
        const float* sc2 = mod + b * 6144 + 4096 + n0;
        float* Fs = (float*)smem;
        __syncthreads();
#pragma unroll
        for (int mi = 0; mi < 2; ++mi)
#pragma unroll
            for (int ni = 0; ni < 2; ++ni)
#pragma unroll
                for (int i = 0; i < 16; ++i)
                    Fs[(wr * 64 + mi * 32 + (i & 3) + 8 * (i >> 2) + 4 * h) * 132 + wc * 64 + ni * 32 + r] = acc[mi][ni][i];
        __syncthreads();
#pragma unroll 4
        for (int j = 0; j < 16; ++j) {
            const int id = tid + 256 * j, row = id >> 5, c4 = id & 31;
            const f32x4 a = *(const f32x4*)(Fs + row * 132 + 4 * c4);
            const size_t go = (size_t)(m0 + row) * DM + n0 + 4 * c4;
            const f32x4 xv = *(const f32x4*)(p.x + go), gv = *(const f32x4*)(gate + 4 * c4);
            const f32x4 ng = *(const f32x4*)(p.norm2_g + n0 + 4 * c4), sv = *(const f32x4*)(sc2 + 4 * c4);
            f32x4 v;
            v.x = xv.x + gv.x * a.x; v.y = xv.y + gv.y * a.y; v.z = xv.z + gv.z * a.z; v.w = xv.w + gv.w * a.w;
            *(f32x4*)(X1 + go) = v;
            u32x2 o; o.x = pack2(v.x * ng.x * (1.f + sv.x), v.y * ng.y * (1.f + sv.y)); o.y = pack2(v.z * ng.z * (1.f + sv.z), v.w * ng.w * (1.f + sv.w));
            *(u32x2*)(X1G + go) = o;
            float ss = v.x * v.x + v.y * v.y + v.z * v.z + v.w * v.w;
            ss = row16_sum(ss);
            ss += dppm<0x142, 0xa>(ss);
            if ((lane & 31) == 31) ss2p[(size_t)(m0 + row) * 8 + nt] = ss;
        }
      }
    }
}

DI unsigned score_key(float s, int idx) {
    unsigned u = __float_as_uint(s);
    u = (u & 0x80000000u) ? ~u : (u | 0x80000000u);
    return (u & ~127u) | (unsigned)idx;
}
DI float key_score(unsigned k) {
    unsigned u = (k & ~127u) | 64u;
    u = (u & 0x80000000u) ? (u & 0x7fffffffu) : ~u;
    return __uint_as_float(u);
}
DI unsigned score_key8(float s, int tag) {
    unsigned u = __float_as_uint(s);
    u = (u & 0x80000000u) ? ~u : (u | 0x80000000u);
    return (u & ~255u) | (unsigned)tag;
}
DI float key_score8(unsigned k) {
    unsigned u = (k & ~255u) | 128u;
    u = (u & 0x80000000u) ? (u & 0x7fffffffu) : ~u;
    return __uint_as_float(u);
}
constexpr int LDS_S = 136;
constexpr int SMEM_RS_OFF = 79616 - 512;
template <int B> DI void sort16_desc(unsigned (&c)[64]) {
#pragma unroll
    for (int k = 2; k <= 16; k <<= 1)
#pragma unroll
        for (int j = k >> 1; j > 0; j >>= 1)
#pragma unroll
            for (int i = 0; i < 16; ++i) {
                const int l = i ^ j;
                if (l > i) {
                    const unsigned hi = max(c[B + i], c[B + l]), lo = min(c[B + i], c[B + l]);
                    const bool desc = (i & k) == 0;
                    c[B + i] = desc ? hi : lo; c[B + l] = desc ? lo : hi;
                }
            }
}
DI void bitonic_merge16_desc(unsigned (&t)[16]) {
#pragma unroll
    for (int j = 8; j > 0; j >>= 1)
#pragma unroll
        for (int i = 0; i < 16; ++i) {
            const int l = i ^ j;
            if (l > i) { const unsigned hi = max(t[i], t[l]), lo = min(t[i], t[l]); t[i] = hi; t[l] = lo; }
        }
}
DI void topk_tile(const f32x16 (&acc)[2][2], unsigned* S, unsigned* __restrict__ dst0, int wr, int wc, int r, int h) {
    const int tid = threadIdx.x;
#pragma unroll
    for (int mi = 0; mi < 2; ++mi)
#pragma unroll
        for (int ni = 0; ni < 2; ++ni)
#pragma unroll
            for (int i = 0; i < 16; ++i) {
                const int row = wr * 64 + mi * 32 + crow(i, h), col = wc * 64 + ni * 32 + r;
                S[row * LDS_S + (col >> 6) * 68 + (col & 63)] = score_key(acc[mi][ni][i], col);
            }
    __syncthreads();
    const int row = tid >> 1, half = tid & 1;
    const unsigned* base = S + row * LDS_S + half * 68;
    unsigned c[64];
#pragma unroll
    for (int j = 0; j < 16; ++j) {
        const u32x4 v = *(const u32x4*)(base + 4 * j);
        c[4 * j] = v.x; c[4 * j + 1] = v.y; c[4 * j + 2] = v.z; c[4 * j + 3] = v.w;
    }
    sort16_desc<0>(c); sort16_desc<16>(c); sort16_desc<32>(c); sort16_desc<48>(c);
    unsigned t[16], u[16];
#pragma unroll
    for (int i = 0; i < 16; ++i) { t[i] = max(c[i], c[31 - i]); u[i] = max(c[32 + i], c[63 - i]); }
    bitonic_merge16_desc(t); bitonic_merge16_desc(u);
#pragma unroll
    for (int i = 0; i < 16; ++i) t[i] = max(t[i], u[15 - i]);
    bitonic_merge16_desc(t);
#pragma unroll
    for (int i = 0; i < 16; ++i) u[i] = (unsigned)__builtin_amdgcn_update_dpp(0, (int)t[15 - i], 0xB1, 0xf, 0xf, false);
#pragma unroll
    for (int i = 0; i < 16; ++i) t[i] = max(t[i], u[i]);
    bitonic_merge16_desc(t);
    unsigned* dst = dst0 + (size_t)row * 256 + half * 8;
    *(u32x4*)dst = half ? (u32x4){t[8], t[9], t[10], t[11]} : (u32x4){t[0], t[1], t[2], t[3]};
    *(u32x4*)(dst + 4) = half ? (u32x4){t[12], t[13], t[14], t[15]} : (u32x4){t[4], t[5], t[6], t[7]};
}

DI void ph6(const Params& p, char* smem, int bid, int nb) {
    const int tid = threadIdx.x, lane = tid & 63, wave = tid >> 6;
    const int wr = wave >> 1, wc = wave & 1, r = lane & 31, h = lane >> 5;
    const float* ss2p = (const float*)(p.ws + OFF_SS2P);
    const float* SW = (const float*)(p.ws + OFF_SW);
    const u16* X1G = (const u16*)(p.ws + OFF_X1G);
    const u16* WT = (const u16*)(p.ws + OFF_WQT);
    const u16* KEYS = (const u16*)(p.ws + OFF_KEYS);
    unsigned* TOPK = (unsigned*)(p.ws + OFF_TOPK);
    int mt, nt;
    for (int rnd = 0; xcd_tile256(bid, nb, rnd, 16, mt, nt); ++rnd) {
        const int n0 = nt * 128;
        f32x16 accs[2][2][2];
#pragma unroll
        for (int hf = 0; hf < 2; ++hf) zero_acc(accs[hf]);
        gemm_bf16A_256(accs, X1G + (size_t)(mt * 256) * DM, DM, WT + (size_t)n0 * DM, DM, 16, smem);
#pragma unroll
        for (int hf = 0; hf < 2; ++hf) {
            f32x16 (&acc)[2][2] = accs[hf];
            const int m0 = mt * 256 + hf * 128, b = m0 / SEQ;
            const u16* kb = KEYS + (size_t)nt * 128 * 128 + (size_t)(wc * 64 + r) * 128 + 8 * h;
            bf16x8 kf0[8], kf1[8];
#pragma unroll
            for (int ks = 0; ks < 8; ++ks) { kf0[ks] = *(const bf16x8*)(kb + ks * 16); kf1[ks] = *(const bf16x8*)(kb + 32 * 128 + ks * 16); }
            const float sw0 = SW[b * 2048 + n0 + wc * 64 + r], sw1 = SW[b * 2048 + n0 + wc * 64 + 32 + r];
            float* rsS = (float*)(smem + SMEM_RS_OFF);
            if (tid < 128) rsS[tid] = rsqrtf(ss2_row(ss2p, m0 + tid) * (1.f / 1024.f) + 1e-6f);
            __syncthreads();
#pragma unroll
            for (int mi = 0; mi < 2; ++mi)
#pragma unroll
                for (int i = 0; i < 16; ++i) {
                    const float rs = rsS[wr * 64 + mi * 32 + crow(i, h)];
                    acc[mi][0][i] = acc[mi][0][i] * rs + sw0; acc[mi][1][i] = acc[mi][1][i] * rs + sw1;
                }
            u16* Os = (u16*)smem;
            __syncthreads();
            stage_tile_bf16<false>(Os, acc, wr, wc, r, h);
            __syncthreads();
            zero_acc(acc);
#pragma unroll
            for (int ks = 0; ks < 8; ++ks) {
                const bf16x8 b0 = kf0[ks], b1 = kf1[ks];
                const bf16x8 a0 = *(const bf16x8*)(Os + (wr * 64 + r) * LDO + ks * 16 + 8 * h);
                const bf16x8 a1 = *(const bf16x8*)(Os + (wr * 64 + 32 + r) * LDO + ks * 16 + 8 * h);
                acc[0][0] = MFMA32(a0, b0, acc[0][0]); acc[0][1] = MFMA32(a0, b1, acc[0][1]);
                acc[1][0] = MFMA32(a1, b0, acc[1][0]); acc[1][1] = MFMA32(a1, b1, acc[1][1]);
            }
            __syncthreads();
            topk_tile(acc, (unsigned*)smem, TOPK + ((size_t)m0 * 16 + nt) * 16, wr, wc, r, h);
            __syncthreads();
        }
    }
}

DI float gelu_as(float v) {
    const float av = fabsf(v), d = av * 0.2316418882f + 1.0f;
    const float t = __builtin_amdgcn_rcpf(d);
    float q = t * 0.5307027145f + (-0.7265760135f); q = q * t + 0.7107068705f; q = q * t + (-0.142248368f); q = q * t + 0.127414796f; q = q * t;
    const float e = __builtin_amdgcn_exp2f((v * v) * (-0.72134752044f));
    const float m = v * (q * e), r = v - m;
    return v < 0.f ? m : r;
}
DI float dot16_fp8(const u32x4 u, const float (&h)[16]) {
    float d0 = 0.f, d1 = 0.f;
#pragma unroll
    for (int w = 0; w < 4; ++w) {
        const f32x2_t lo = __builtin_amdgcn_cvt_pk_f32_fp8((int)u[w], false), hi = __builtin_amdgcn_cvt_pk_f32_fp8((int)u[w], true);
        d0 = fma_(lo.x, h[4 * w + 0], d0); d1 = fma_(lo.y, h[4 * w + 1], d1);
        d0 = fma_(hi.x, h[4 * w + 2], d0); d1 = fma_(hi.y, h[4 * w + 3], d1);
    }
    return d0 + d1;
}
DI void axpy16_fp8(float (&acc)[16], const float wgt, const u32x4 v) {
#pragma unroll
    for (int w = 0; w < 4; ++w) {
        const f32x2_t lo = __builtin_amdgcn_cvt_pk_f32_fp8((int)v[w], false), hi = __builtin_amdgcn_cvt_pk_f32_fp8((int)v[w], true);
        acc[4 * w + 0] = fma_(wgt, lo.x, acc[4 * w + 0]); acc[4 * w + 1] = fma_(wgt, lo.y, acc[4 * w + 1]);
        acc[4 * w + 2] = fma_(wgt, hi.x, acc[4 * w + 2]); acc[4 * w + 3] = fma_(wgt, hi.y, acc[4 * w + 3]);
    }
}
DI float wave_total(float x) {
    x = row16_sum(x);
    x += dppm<0x142, 0xa>(x);
    x += dppm<0x143, 0xc>(x);
    return __builtin_bit_cast(float, __builtin_amdgcn_readlane(__builtin_bit_cast(int, x), 63));
}
struct Rows8 { u32x4 r[8]; };
DI void g8_load(Rows8& rw, const unsigned* skey, int g, const unsigned char* T8, const unsigned char* T8hi, int split, int lane) {
#pragma unroll
    for (int q = 0; q < 8; ++q) {
        const int e = (int)__builtin_amdgcn_readfirstlane(skey[(q >> 2) * 128 + 4 * g + (q & 3)]);
        rw.r[q] = *(const u32x4*)((e < split ? T8 : T8hi) + (size_t)e * 1024 + 16 * lane);
    }
}
DI float g8_reduce(const float (&d)[8], int lane) {
    const bool b0 = lane & 1, b1 = lane & 2, b2 = lane & 4;
    float r4[4], s2[2];
#pragma unroll
    for (int j = 0; j < 4; ++j) { const float keep = b0 ? d[j + 4] : d[j], send = b0 ? d[j] : d[j + 4]; r4[j] = keep + dppmov<0xB1>(send); }
#pragma unroll
    for (int j = 0; j < 2; ++j) { const float keep = b1 ? r4[j + 2] : r4[j], send = b1 ? r4[j] : r4[j + 2]; s2[j] = keep + dppmov<0x4E>(send); }
    const float keep = b2 ? s2[1] : s2[0], send = b2 ? s2[0] : s2[1];
    float t = keep + __builtin_bit_cast(float, __builtin_amdgcn_ds_swizzle(__builtin_bit_cast(int, send), 0x101F));
    t += dppmov<0x128>(t);
    t += __builtin_bit_cast(float, __builtin_amdgcn_ds_swizzle(__builtin_bit_cast(int, t), 0x401F));
    t += __shfl_xor(t, 32);
    return t;
}
DI float g8_dot(const u32x4 u, const f32x2_t (&h2)[8]) {
    f32x2_t a0 = {0.f, 0.f}, a1 = {0.f, 0.f};
#pragma unroll
    for (int w = 0; w < 4; ++w) {
        const f32x2_t lo = __builtin_amdgcn_cvt_pk_f32_fp8((int)u[w], false), hi = __builtin_amdgcn_cvt_pk_f32_fp8((int)u[w], true);
        a0 = __builtin_elementwise_fma(lo, h2[2 * w], a0); a1 = __builtin_elementwise_fma(hi, h2[2 * w + 1], a1);
    }
    a0 += a1;
    return a0.x + a0.y;
}
DI void g8_axpy(f32x2_t (&acc)[8], const float wgt, const u32x4 v) {
    const f32x2_t w2 = {wgt, wgt};
#pragma unroll
    for (int w = 0; w < 4; ++w) {
        const f32x2_t lo = __builtin_amdgcn_cvt_pk_f32_fp8((int)v[w], false), hi = __builtin_amdgcn_cvt_pk_f32_fp8((int)v[w], true);
        acc[2 * w] = __builtin_elementwise_fma(w2, lo, acc[2 * w]); acc[2 * w + 1] = __builtin_elementwise_fma(w2, hi, acc[2 * w + 1]);
    }
}
constexpr int TPW = 2;
DI void ph7(const Params& p, char* smem, int bid, int nb) {
    const int tid = threadIdx.x, lane = tid & 63, wave = tid >> 6;
    unsigned* ekey8 = (unsigned*)(smem + wave * 10752);
    float* egate8 = (float*)(ekey8 + 1024);
    unsigned* skey = (unsigned*)(egate8 + 1024); float* sgate = (float*)(skey + 256);
    unsigned* cnt = (unsigned*)(sgate + 256);
    const unsigned* TOPK = (const unsigned*)(p.ws + OFF_TOPK);
    const float* X1 = (const float*)(p.ws + OFF_X1);
    const float* ss2p = (const float*)(p.ws + OFF_SS2P);
    const float* mod = (const float*)(p.ws + OFF_MOD);
    const unsigned char* U8 = p.ws + OFF_U8; const unsigned char* V8A = p.ws + OFF_V8A; const unsigned char* V8B = p.ws + OFF_V8B - (size_t)V8_SPLIT * 1024;
    const float* usc = (const float*)(p.ws + OFF_USC); const float* vsc = (const float*)(p.ws + OFF_VSC);
    const int nwaves = nb * 4, gw = bid * 4 + wave;
    for (int tokc = gw * TPW; tokc < NTOK; tokc += 4 * nwaves * TPW) {
      {
          const int slot = lane >> 3, hd = lane & 7;
          const int tok = tokc + (slot >> 1) * nwaves * TPW + (slot & 1);
          if (tok < NTOK) {
              const unsigned* l1 = TOPK + (size_t)tok * 256 + hd * 32; const unsigned* l2 = l1 + 16;
              float s1[16], s2[16];
#pragma unroll
              for (int q = 0; q < 4; ++q) {
                  const u32x4 a = *(const u32x4*)(l1 + 4 * q), bb = *(const u32x4*)(l2 + 4 * q);
                  s1[4 * q] = key_score(a.x); s1[4 * q + 1] = key_score(a.y); s1[4 * q + 2] = key_score(a.z); s1[4 * q + 3] = key_score(a.w);
                  s2[4 * q] = key_score(bb.x); s2[4 * q + 1] = key_score(bb.y); s2[4 * q + 2] = key_score(bb.z); s2[4 * q + 3] = key_score(bb.w);
              }
              unsigned c[64];
#pragma unroll
              for (int n = 0; n < 64; ++n) c[n] = 0u;
              {
                  int n = 0;
#pragma unroll
                  for (int i = 0; i < 16; ++i)
#pragma unroll
                      for (int j = 0; j < 16; ++j)
                          if ((i + 1) * (j + 1) <= 16) { c[n] = score_key8(s1[i] + s2[j], i * 16 + j); ++n; }
              }
              sort16_desc<0>(c); sort16_desc<16>(c); sort16_desc<32>(c); sort16_desc<48>(c);
              unsigned t[16], u[16];
#pragma unroll
              for (int i = 0; i < 16; ++i) { t[i] = max(c[i], c[31 - i]); u[i] = max(c[32 + i], c[63 - i]); }
              bitonic_merge16_desc(t); bitonic_merge16_desc(u);
#pragma unroll
              for (int i = 0; i < 16; ++i) t[i] = max(t[i], u[15 - i]);
              bitonic_merge16_desc(t);
              const float mx = key_score8(t[0]);
              float ex[16], den = 0.f;
#pragma unroll
              for (int k = 0; k < 16; ++k) { ex[k] = __expf(key_score8(t[k]) - mx); den += ex[k]; }
              const float iden = 1.f / den;
#pragma unroll
              for (int k = 0; k < 16; ++k) {
                  const unsigned e1 = l1[(t[k] >> 4) & 15u] & 127u, e2 = l2[t[k] & 15u] & 127u;
                  ekey8[slot * 128 + hd * 16 + k] = e1 * 128u + e2;
                  egate8[slot * 128 + hd * 16 + k] = ex[k] * iden;
              }
          }
      }
#pragma unroll 1
      for (int rnd = 0; rnd < 4; ++rnd) {
        const int tok0 = tokc + rnd * nwaves * TPW;
        if (tok0 >= NTOK) break;
        const unsigned* ekey = ekey8 + rnd * 256; const float* egate = egate8 + rnd * 256;
        cnt[lane] = 0u; cnt[64 + lane] = 0u;
        unsigned mykey[4]; float mygate[4];
#pragma unroll
        for (int j = 0; j < 4; ++j) { mykey[j] = ekey[lane + 64 * j]; mygate[j] = egate[lane + 64 * j]; }
        const unsigned bflip = (rnd & 1) ? 63u : 0u;
#pragma unroll
        for (int j = 0; j < 4; ++j) atomicAdd(&cnt[(j >> 1) * 64 + ((mykey[j] >> 8) ^ bflip)], 1u);
#pragma unroll
        for (int ts = 0; ts < 2; ++ts) {
            const unsigned c = cnt[ts * 64 + lane];
            unsigned incl = c;
#pragma unroll
            for (int d = 1; d < 64; d <<= 1) { const unsigned t = __shfl_up(incl, d); if (lane >= d) incl += t; }
            cnt[ts * 64 + lane] = incl - c;
        }
#pragma unroll
        for (int j = 0; j < 4; ++j) {
            const unsigned pos = atomicAdd(&cnt[(j >> 1) * 64 + ((mykey[j] >> 8) ^ bflip)], 1u);
            skey[(j >> 1) * 128 + pos] = mykey[j]; sgate[(j >> 1) * 128 + pos] = mygate[j];
        }
        f32x2_t hv[TPW][8];
#pragma unroll
        for (int ts = 0; ts < TPW; ++ts) {
            const int tok = tok0 + ts, b = tok / SEQ;
            const float rs = rsqrtf(ss2_row(ss2p, tok) * (1.f / 1024.f) + 1e-6f);
            const u16* xg = (const u16*)(p.ws + OFF_X1G) + (size_t)tok * DM + 16 * lane;
            const float* gsh = mod + b * 6144 + 3072 + 16 * lane;
            float xf[16];
            load8(xg, *(float(*)[8])&xf[0]); load8(xg + 8, *(float(*)[8])&xf[8]);
#pragma unroll
            for (int q = 0; q < 4; ++q) {
                const f32x4 hh = *(const f32x4*)(gsh + 4 * q);
                hv[ts][2 * q].x = xf[4 * q] * rs + hh.x;
                hv[ts][2 * q].y = xf[4 * q + 1] * rs + hh.y;
                hv[ts][2 * q + 1].x = xf[4 * q + 2] * rs + hh.z;
                hv[ts][2 * q + 1].y = xf[4 * q + 3] * rs + hh.w;
            }
        }
        f32x2_t oacc[TPW][8];
#pragma unroll
        for (int ts = 0; ts < TPW; ++ts)
#pragma unroll
            for (int j = 0; j < 8; ++j) oacc[ts][j] = (f32x2_t){0.f, 0.f};
        const int myq = 4 * (lane & 1) + (lane & 2) + ((lane >> 2) & 1);
        const int mypos = (myq >> 2) * 128 + (myq & 3);
        Rows8 ur, vr;
        g8_load(ur, skey, 0, U8, U8, 16384, lane);
#pragma unroll 1
        for (int g = 0; g < 32; ++g) {
            g8_load(vr, skey, g, V8A, V8B, V8_SPLIT, lane);
            const int mye = (int)skey[mypos + 4 * g];
            const float myus = usc[mye], myvs = vsc[mye], mygt = sgate[mypos + 4 * g];
            float d[8];
#pragma unroll
            for (int q = 0; q < 8; ++q) d[q] = g8_dot(ur.r[q], hv[q >> 2]);
            if (g + 1 < 32) g8_load(ur, skey, g + 1, U8, U8, 16384, lane);
            const float tot = g8_reduce(d, lane);
            const int wbits = __builtin_bit_cast(int, mygt * gelu_as(tot * myus) * myvs);
#pragma unroll
            for (int q = 0; q < 8; ++q) {
                const float w = __builtin_bit_cast(float, __builtin_amdgcn_readlane(wbits, ((q >> 2) & 1) + 2 * ((q >> 1) & 1) + 4 * (q & 1)));
                g8_axpy(oacc[q >> 2], w, vr.r[q]);
            }
        }
#pragma unroll
        for (int ts = 0; ts < TPW; ++ts) {
            const int tok = tok0 + ts, b = tok / SEQ;
            const float* xr = X1 + (size_t)tok * DM + 16 * lane; const float* g2v = mod + b * 6144 + 5120 + 16 * lane;
            float* orow = p.out + (size_t)tok * DM + 16 * lane;
#pragma unroll
            for (int q = 0; q < 4; ++q) {
                const f32x4 xv = *(const f32x4*)(xr + 4 * q), gv = *(const f32x4*)(g2v + 4 * q);
                f32x4 o;
                o.x = xv.x + gv.x * oacc[ts][2 * q].x; o.y = xv.y + gv.y * oacc[ts][2 * q].y;
                o.z = xv.z + gv.z * oacc[ts][2 * q + 1].x; o.w = xv.w + gv.w * oacc[ts][2 * q + 1].y;
                *(f32x4*)(orow + 4 * q) = o;
            }
        }
      }
    }
}

#if defined(__HIP_DEVICE_COMPILE__)
typedef const Params __attribute__((address_space(4)))* KargPtr;
DI Params kargs() { KargPtr k = (KargPtr)__builtin_amdgcn_kernarg_segment_ptr(); asm volatile("" : "+s"(k)); return *k; }
#define PK kargs()
#else
#define PK p
#endif
constexpr int SMEM_BYTES = 79616;
__global__ void __launch_bounds__(256, 2) fwd_megakernel(Params p) {
    cg::grid_group grid = cg::this_grid();
    __shared__ __attribute__((aligned(16))) char smem[SMEM_BYTES];
    __shared__ __attribute__((aligned(16))) unsigned xb_words[4];
    if (threadIdx.x == 0) { xb_words[0] = 0u; xb_words[1] = 0u; xb_words[2] = 0u; xb_words[3] = 0u; }
    __syncthreads();
    XcdBarrier bar = xcd_barrier_post((unsigned*)(p.ws + OFF_BAR), (volatile LAS unsigned*)xb_words);
    const int bid = blockIdx.x, nb = gridDim.x;

    ph0(PK, smem, bid, nb);
    xcd_barrier(bar);
    ph1a(PK, bid, nb);
    xcd_barrier(bar);
    ph1(PK, smem, bid, nb);
    xcd_barrier(bar);
    ph2a(PK, bid, nb);
    ph2b(PK, smem, bid, nb);
    xcd_barrier(bar);
    for (int chain = bid; chain < 128; chain += nb) ph3c_chain(PK, smem, chain);
    {
        int abid = bid, anb = nb;
        xcd_barrier(bar);
        if (abid >= 0) {
            const int rem = (NB * 4 * 32) % anb, cb = rem ? abid - rem : abid, cn = rem ? anb - rem : anb;
            ph2c(PK, smem, abid, anb);
            if (cb >= 0) {
                { const Params pl = PK; convert_fp8_rows(pl.U, pl.ws + OFF_U8, pl.ws + OFF_U8, 16384, (float*)(pl.ws + OFF_USC), cb, cn); }
                { const Params pl = PK; convert_fp8_rows(pl.V, pl.ws + OFF_V8A, pl.ws + OFF_V8B, V8_SPLIT, (float*)(pl.ws + OFF_VSC), cb, cn); }
            }
        }
    }
    xcd_barrier(bar);
    ph4(PK, bid, nb);
    xcd_barrier(bar);
    ph5(PK, smem, bid, nb);
    xcd_barrier(bar);
    ph6(PK, smem, bid, nb);
    xcd_barrier(bar);
    ph7(PK, smem, bid, nb);
}

extern "C" void kernel_launch(void* const* d_in, const int* in_sizes, int n_in,
                              void* d_out, int out_size, void* d_ws, size_t ws_size,
                              hipStream_t stream) {
    static int grid_blocks = 0;
    if (!grid_blocks) {
        int dev = 0, cus = 0, per_cu = 0;
        (void)hipGetDevice(&dev);
        (void)hipDeviceGetAttribute(&cus, hipDeviceAttributeMultiprocessorCount, dev);
        (void)hipOccupancyMaxActiveBlocksPerMultiprocessor(&per_cu, fwd_megakernel, 256, 0);
        if (per_cu > 2) per_cu = 2;
        if (per_cu < 1) per_cu = 1;
        grid_blocks = cus * per_cu;
    }
    (void)hipMemsetAsync(d_ws, 0, 65536, stream);
    Params p{};
    const float** pp = (const float**)&p;
    for (int i = 0; i < 27; ++i) pp[i] = (const float*)d_in[i];
    p.out = (float*)d_out; p.ws = (unsigned char*)d_ws;
    void* args[] = {&p};
    hipError_t e = hipLaunchCooperativeKernel((void*)fwd_megakernel, dim3(grid_blocks), dim3(256), args, 0, stream);
    if (e != hipSuccess) fprintf(stderr, "cooperative launch failed: %s (grid %d)\n", hipGetErrorString(e), grid_blocks);
}
```

```cpp
#include <hip/hip_runtime.h>
#include <hip/hip_cooperative_groups.h>
#include <stdint.h>
#include <cstdio>
namespace cg = cooperative_groups;

#define DI __device__ __forceinline__
typedef unsigned short u16;
using bf16x8 = __attribute__((ext_vector_type(8))) short;
using f32x16 = __attribute__((ext_vector_type(16))) float;
typedef __bf16 bf16x2_t __attribute__((ext_vector_type(2)));
typedef float f32x2_t __attribute__((ext_vector_type(2)));
typedef unsigned u32x4 __attribute__((ext_vector_type(4)));
typedef unsigned u32x2 __attribute__((ext_vector_type(2)));
typedef float f32x4 __attribute__((ext_vector_type(4)));
#define MFMA32(a, b, c) __builtin_amdgcn_mfma_f32_32x32x16_bf16((a), (b), (c), 0, 0, 0)

constexpr int NTOK = 16384, SEQ = 2048, DM = 1024, NB = 8;
constexpr int INC = 3456, RWC = 1920;
constexpr float LOG2E = 1.4426950408889634f;

constexpr size_t OFF_BAR   = 0;
constexpr size_t OFF_MOD   = 65536;
constexpr size_t OFF_RSTD1 = OFF_MOD + 8 * 6144 * 4;
constexpr size_t OFF_SS2   = OFF_RSTD1 + 65536;
constexpr size_t OFF_SW    = OFF_SS2 + 65536;
constexpr size_t OFF_W2T   = OFF_SW + 65536;
constexpr size_t OFF_A2T   = OFF_W2T + 131072;
constexpr size_t OFF_G2T   = OFF_A2T + 131072;
constexpr size_t OFF_KEYS  = OFF_G2T + 131072;
constexpr size_t OFF_WOUTT = OFF_KEYS + 524288;
constexpr size_t OFF_WQT   = OFF_WOUTT + 2097152;
constexpr size_t OFF_WINT  = OFF_WQT + 4194304;
constexpr size_t OFF_PRW   = OFF_WINT + 7077888;
constexpr size_t SZ_PRW    = (size_t)NTOK * RWC * 2;
constexpr size_t OFF_YF    = OFF_PRW;
constexpr size_t OFF_YB    = OFF_PRW + (size_t)NTOK * 512 * 2;
constexpr size_t OFF_U8    = OFF_PRW + (size_t)NTOK * 1024 * 2;
constexpr size_t OFF_V8A   = OFF_U8 + (size_t)16384 * 1024;
constexpr int    V8_SPLIT  = 12288;
static_assert(OFF_V8A + (size_t)V8_SPLIT * 1024 <= OFF_PRW + SZ_PRW, "fp8 tables overflow");
constexpr size_t OFF_GB    = OFF_PRW + SZ_PRW;
constexpr size_t OFF_G     = OFF_GB;
constexpr size_t OFF_BONUS = OFF_GB + (size_t)NTOK * 512 * 2;
constexpr size_t OFF_X1G   = OFF_GB;
constexpr size_t OFF_R     = OFF_GB + (size_t)NTOK * 1024 * 2;
constexpr size_t OFF_RS    = OFF_R;
constexpr size_t OFF_KS    = OFF_RS + (size_t)NTOK * 512 * 2;
constexpr size_t OFF_VS    = OFF_KS + (size_t)NTOK * 512 * 2;
constexpr size_t OFF_INVN  = OFF_VS + (size_t)NTOK * 512 * 2;
constexpr size_t OFF_DEC   = OFF_INVN + (size_t)NTOK * 8 * 4;
constexpr size_t OFF_AA    = OFF_DEC + (size_t)2 * NTOK * 512 * 4;
constexpr size_t OFF_REND  = OFF_AA + (size_t)2 * NTOK * 512 * 2;
constexpr size_t OFF_V8B   = OFF_REND;
constexpr size_t OFF_USC   = OFF_V8B + (size_t)(16384 - V8_SPLIT) * 1024;
constexpr size_t OFF_VSC   = OFF_USC + 65536;
constexpr size_t OFF_SS2P  = OFF_VSC + 65536;
static_assert(OFF_SS2P + (size_t)NTOK * 8 * 4 <= 268435456ull, "workspace overflow");
constexpr size_t OFF_H1    = OFF_R;
constexpr size_t OFF_RWOUT = OFF_R;
constexpr size_t OFF_TOPK  = OFF_R;
constexpr size_t OFF_X1    = OFF_R + (size_t)NTOK * 512 * 2;
constexpr size_t OFF_Q2    = OFF_X1 + (size_t)NTOK * 1024 * 4;
constexpr size_t OFF_Q2END = OFF_Q2 + (size_t)NTOK * 2048 * 2;
static_assert(OFF_Q2END <= OFF_REND, "overlay overflow");
static_assert(OFF_REND <= 268435456ull, "workspace overflow");
constexpr size_t OUT_QK = 0;
constexpr size_t OUT_VT = (size_t)NTOK * 1024 * 2;
constexpr size_t OUT_ATT = 50331648;

#define XB_TMO      128
#define XB_XCNT(j)  (256  + 64 * (j))
#define XB_XSUB(j)  (1280 + 64 * (j))
#define XB_XGEN(j)  (2304 + 64 * (j))
#define XB_TOP      3328
#define XB_TOPGEN   3392
#define XCD_BAR_WORDS 3456
#define XB_SPIN_CAP (1u << 20)
#define LAS __attribute__((address_space(3)))

DI unsigned xb_ld(unsigned* p)              { return __hip_atomic_load(p, __ATOMIC_RELAXED, __HIP_MEMORY_SCOPE_AGENT); }
DI unsigned xb_add(unsigned* p, unsigned v) { return __hip_atomic_fetch_add(p, v, __ATOMIC_RELAXED, __HIP_MEMORY_SCOPE_AGENT); }
DI unsigned xb_xcc_id() { return (unsigned)__builtin_amdgcn_s_getreg((3 << 11) | 20) & 0xFu; }
#define XB_SPIN(cond, bar) do { unsigned _sp = 0; while (cond) { __builtin_amdgcn_s_sleep(1); \
    if ((++_sp & 255u) == 0u) { if (xb_ld(&(bar)[XB_TMO])) break; if (_sp > XB_SPIN_CAP) { atomicAdd(&(bar)[XB_TMO], 1u); break; } } } } while (0)

struct XcdBarrier { unsigned* bar; unsigned x; volatile LAS unsigned* st; };

DI XcdBarrier xcd_barrier_post(unsigned* bar, volatile LAS unsigned* st) {
    XcdBarrier b; b.bar = bar; b.x = xb_xcc_id(); b.st = st;
    if (threadIdx.x == 0) (void)xb_add(&bar[XB_XCNT(b.x)], 1u);
    return b;
}
DI void xcd_barrier_complete(unsigned* bar, unsigned x, unsigned& nloc, unsigned& nx) {
    const unsigned G = gridDim.x * gridDim.y * gridDim.z;
    unsigned sum, cnt, mine, sp = 0u;
    for (;;) {
        sum = 0u; cnt = 0u; mine = 0u;
#pragma unroll
        for (unsigned j = 0; j < 16; ++j) { const unsigned c = xb_ld(&bar[XB_XCNT(j)]); sum += c; cnt += (c > 0u) ? 1u : 0u; mine = (j == x) ? c : mine; }
        if (sum == G) break;
        __builtin_amdgcn_s_sleep(1);
        if ((++sp & 255u) == 0u) { if (xb_ld(&bar[XB_TMO])) break; if (sp > XB_SPIN_CAP) { atomicAdd(&bar[XB_TMO], 1u); break; } }
    }
    nloc = mine > 0u ? mine : 1u; nx = cnt > 0u ? cnt : 1u;
}
DI void xcd_barrier(const XcdBarrier& b) {
    asm volatile("s_waitcnt vmcnt(0)" ::: "memory");
    __syncthreads();
    if (threadIdx.x == 0) {
        unsigned* bar = b.bar;
        __builtin_amdgcn_s_waitcnt(0);
        unsigned nloc = b.st[0], nx = b.st[1];
        if (nloc == 0u) { xcd_barrier_complete(bar, b.x, nloc, nx); b.st[0] = nloc; b.st[1] = nx; }
        const unsigned old = xb_add(&bar[XB_XSUB(b.x)], 1u);
        const unsigned gen = old / nloc;
        if (old + 1u == (gen + 1u) * nloc) {
            __builtin_amdgcn_fence(__ATOMIC_RELEASE, "agent");
            asm volatile("s_waitcnt vmcnt(0)" ::: "memory");
            const unsigned og = xb_add(&bar[XB_TOP], 1u);
            const unsigned tg = og / nx;
            if (og + 1u == (tg + 1u) * nx) xb_add(&bar[XB_TOPGEN], 1u);
            else XB_SPIN(xb_ld(&bar[XB_TOPGEN]) == tg, bar);
            __builtin_amdgcn_fence(__ATOMIC_ACQUIRE, "agent");
            xb_add(&bar[XB_XGEN(b.x)], 1u);
            asm volatile("s_waitcnt vmcnt(0)" ::: "memory");
        } else {
            XB_SPIN(xb_ld(&bar[XB_XGEN(b.x)]) == gen, bar);
            __builtin_amdgcn_fence(__ATOMIC_ACQUIRE, "agent");
            asm volatile("s_waitcnt vmcnt(0)" ::: "memory");
        }
    }
    __syncthreads();
}

DI float ss2_row(const float* ss2p, int row) {
    const float4 a = *(const float4*)(ss2p + (size_t)row * 8), b = *(const float4*)(ss2p + (size_t)row * 8 + 4);
    return ((a.x + a.y) + (a.z + a.w)) + ((b.x + b.y) + (b.z + b.w));
}
DI unsigned pack2(float lo, float hi) {
    f32x2_t v = {lo, hi};
    bf16x2_t b = __builtin_convertvector(v, bf16x2_t);
    return __builtin_bit_cast(unsigned, b);
}
DI u16 f2bf(float x) { return (u16)(pack2(x, 0.f) & 0xffffu); }
DI float bf2f(u16 b) { return __uint_as_float((unsigned)b << 16); }
DI float bflo(unsigned u) { return __uint_as_float(u << 16); }
DI float bfhi(unsigned u) { return __uint_as_float(u & 0xffff0000u); }
DI int crow(int reg, int h) { return (reg & 3) + 8 * (reg >> 2) + 4 * h; }
template <int CTRL> DI float dppmov(float x) {
    return __builtin_bit_cast(float, __builtin_amdgcn_update_dpp(0, __builtin_bit_cast(int, x), CTRL, 0xf, 0xf, false));
}
template <int CTRL, int RM> DI float dppm(float x) {
    return __builtin_bit_cast(float, __builtin_amdgcn_update_dpp(0, __builtin_bit_cast(int, x), CTRL, RM, 0xf, false));
}
DI float row16_sum(float x) {
    x += dppmov<0xB1>(x);  x += dppmov<0x4E>(x);  x += dppmov<0x124>(x);  x += dppmov<0x128>(x);
    return x;
}
DI float grp8_sum(float x) { x += __shfl_xor(x, 1); x += __shfl_xor(x, 2); x += __shfl_xor(x, 4); return x; }
DI float half_sum(float x) { x = row16_sum(x); x += __shfl_xor(x, 16); return x; }
DI float wave_sum(float x) { x = half_sum(x); x += __shfl_xor(x, 32); return x; }
DI float wave_max(float x) {
    x = fmaxf(x, __shfl_xor(x, 1)); x = fmaxf(x, __shfl_xor(x, 2)); x = fmaxf(x, __shfl_xor(x, 4));
    x = fmaxf(x, __shfl_xor(x, 8)); x = fmaxf(x, __shfl_xor(x, 16)); x = fmaxf(x, __shfl_xor(x, 32)); return x;
}
DI float fma_(float a, float b, float c) { float d; asm("v_fma_f32 %0, %1, %2, %3" : "=v"(d) : "v"(a), "v"(b), "v"(c)); return d; }
DI float mul_(float a, float b) { float d; asm("v_mul_f32 %0, %1, %2" : "=v"(d) : "v"(a), "v"(b)); return d; }
DI float add_(float a, float b) { float d; asm("v_add_f32 %0, %1, %2" : "=v"(d) : "v"(a), "v"(b)); return d; }
DI float sigmoidf_(float x) { return 1.f / (1.f + __expf(-x)); }

DI void load8(const u16* ptr, float (&o)[8]) {
    const u32x4 u = *(const u32x4*)ptr;
    o[0] = bflo(u.x); o[1] = bfhi(u.x); o[2] = bflo(u.y); o[3] = bfhi(u.y); o[4] = bflo(u.z); o[5] = bfhi(u.z); o[6] = bflo(u.w); o[7] = bfhi(u.w);
}
DI void store8(u16* ptr, const float (&v)[8]) {
    u32x4 o; o.x = pack2(v[0], v[1]); o.y = pack2(v[2], v[3]); o.z = pack2(v[4], v[5]); o.w = pack2(v[6], v[7]);
    *(u32x4*)ptr = o;
}
struct Params {
    const float *x, *c, *ada_w, *ada_b, *norm1_g, *w_in, *qn_g, *kn_g, *da_lambda, *subln_g,
                *mu, *w0, *w2, *a0, *a2, *g2, *k_k, *k_a, *r_k, *ln_g, *ln_b, *w_out, *norm2_g,
                *wq, *keys, *U, *V;
    float* out; unsigned char* ws;
};

DI void transpose_convert(const float* __restrict__ src, u16* __restrict__ dst, int R, int C, float* tile, int bid, int nb) {
    const int tid = threadIdx.x;
    const int tr_n = R / 64, tc_n = C / 64;
    for (int it = bid; it < tr_n * tc_n; it += nb) {
        const int tr = it / tc_n, tc = it % tc_n;
        __syncthreads();
#pragma unroll
        for (int i = 0; i < 4; ++i) {
            const int r = (tid >> 4) + 16 * i, c4 = tid & 15;
            const f32x4 v = *(const f32x4*)(src + (size_t)(64 * tr + r) * C + 64 * tc + 4 * c4);
            tile[r * 65 + 4 * c4 + 0] = v.x; tile[r * 65 + 4 * c4 + 1] = v.y; tile[r * 65 + 4 * c4 + 2] = v.z; tile[r * 65 + 4 * c4 + 3] = v.w;
        }
        __syncthreads();
#pragma unroll
        for (int i = 0; i < 2; ++i) {
            const int c = (tid >> 3) + 32 * i, r8 = (tid & 7) * 8;
            u32x4 o;
            o.x = pack2(tile[(r8 + 0) * 65 + c], tile[(r8 + 1) * 65 + c]);
            o.y = pack2(tile[(r8 + 2) * 65 + c], tile[(r8 + 3) * 65 + c]);
            o.z = pack2(tile[(r8 + 4) * 65 + c], tile[(r8 + 5) * 65 + c]);
            o.w = pack2(tile[(r8 + 6) * 65 + c], tile[(r8 + 7) * 65 + c]);
            *(u32x4*)(dst + (size_t)(64 * tc + c) * R + 64 * tr + r8) = o;
        }
    }
    __syncthreads();
}
DI void convert_bf16(const float* __restrict__ src, u16* __restrict__ dst, size_t n, int bid, int nb) {
    const size_t n8 = n / 8;
    for (size_t i = (size_t)bid * 256 + threadIdx.x; i < n8; i += (size_t)nb * 256) {
        const f32x4 a = *(const f32x4*)(src + i * 8), b = *(const f32x4*)(src + i * 8 + 4);
        u32x4 o; o.x = pack2(a.x, a.y); o.y = pack2(a.z, a.w); o.z = pack2(b.x, b.y); o.w = pack2(b.z, b.w);
        *(u32x4*)(dst + i * 8) = o;
    }
}

DI void ph0(const Params& p, char* smem, int bid, int nb) {
    const int tid = threadIdx.x, lane = tid & 63, wave = tid >> 6;
    {
        float* sc = (float*)smem;
        float* red = sc + 8 * 1024;
        float* mod = (float*)(p.ws + OFF_MOD);
        bool loaded = false;
        for (int it = bid; it < 96; it += nb) {
            if (!loaded) {
                for (int i = tid; i < 8 * 1024; i += 256) { const float v = p.c[i]; sc[i] = v / (1.f + __expf(-v)); }
                loaded = true;
            }
            __syncthreads();
            const int col = tid & 63, kq = tid >> 6;
            float acc[8];
#pragma unroll
            for (int b = 0; b < 8; ++b) acc[b] = 0.f;
            for (int k = kq * 256; k < kq * 256 + 256; ++k) {
                const float w = p.ada_w[(size_t)k * 6144 + 64 * it + col];
#pragma unroll
                for (int b = 0; b < 8; ++b) acc[b] += sc[b * 1024 + k] * w;
            }
#pragma unroll
            for (int b = 0; b < 8; ++b) red[(kq * 8 + b) * 64 + col] = acc[b];
            __syncthreads();
            for (int e = tid; e < 512; e += 256) {
                const int b = e >> 6, cc = e & 63;
                const float v = red[(0 * 8 + b) * 64 + cc] + red[(1 * 8 + b) * 64 + cc] + red[(2 * 8 + b) * 64 + cc] + red[(3 * 8 + b) * 64 + cc];
                mod[b * 6144 + 64 * it + cc] = v + p.ada_b[64 * it + cc];
            }
        }
        __syncthreads();
    }
    float* tile = (float*)smem;
    transpose_convert(p.w_in, (u16*)(p.ws + OFF_WINT), 1024, INC, tile, bid, nb);
    transpose_convert(p.w_out, (u16*)(p.ws + OFF_WOUTT), 1024, 1024, tile, bid, nb);
    transpose_convert(p.wq, (u16*)(p.ws + OFF_WQT), 1024, 2048, tile, bid, nb);
    for (int d = 0; d < 2; ++d) {
        transpose_convert(p.w2 + (size_t)d * 64 * 512, (u16*)(p.ws + OFF_W2T) + (size_t)d * 512 * 64, 64, 512, tile, bid, nb);
        transpose_convert(p.a2 + (size_t)d * 64 * 512, (u16*)(p.ws + OFF_A2T) + (size_t)d * 512 * 64, 64, 512, tile, bid, nb);
    }
    transpose_convert(p.g2, (u16*)(p.ws + OFF_G2T), 128, 512, tile, bid, nb);
    convert_bf16(p.keys, (u16*)(p.ws + OFF_KEYS), (size_t)16 * 128 * 128, bid, nb);
}

constexpr int LDT = 72;
constexpr int GEMM_SMEM = 2 * 128 * LDT * 2;

DI void gemm_compute_tile(f32x16 (&acc)[2][2], const u16* As, const u16* Bs, int wr, int wc, int r, int h) {
#pragma unroll
    for (int ks = 0; ks < 4; ++ks) {
        const bf16x8 a0 = *(const bf16x8*)(As + (wr * 64 + r) * LDT + ks * 16 + 8 * h);
        const bf16x8 a1 = *(const bf16x8*)(As + (wr * 64 + 32 + r) * LDT + ks * 16 + 8 * h);
        const bf16x8 b0 = *(const bf16x8*)(Bs + (wc * 64 + r) * LDT + ks * 16 + 8 * h);
        const bf16x8 b1 = *(const bf16x8*)(Bs + (wc * 64 + 32 + r) * LDT + ks * 16 + 8 * h);
        acc[0][0] = MFMA32(a0, b0, acc[0][0]);
        acc[0][1] = MFMA32(a0, b1, acc[0][1]);
        acc[1][0] = MFMA32(a1, b0, acc[1][0]);
        acc[1][1] = MFMA32(a1, b1, acc[1][1]);
    }
}

DI bool xcd_tile(int bid, int nb, int rnd, int NT, int& mt, int& nt) {
    if (nb & 7) { const int it = bid + rnd * nb; if (it >= 128 * NT) return false; mt = it / NT; nt = it - mt * NT; return true; }
    const int x = bid & 7, j = bid >> 3, per = nb >> 3;
    const int t = rnd * per + j;
    if (t >= 16 * NT) return false;
    const int half = (t >= 8 * NT) ? 1 : 0, u = t - half * 8 * NT;
    nt = u >> 3; mt = x * 16 + half * 8 + (u & 7);
    return true;
}
constexpr int GEMM_STAGE = 2 * 128 * LDT;
DI void gemm_bf16A(f32x16 (&acc)[2][2], const u16* __restrict__ A, int lda, const u16* __restrict__ Bt, int ldb, int nk, char* smem) {
    u16* S0 = (u16*)smem;
    const int tid = threadIdx.x, lane = tid & 63, wave = tid >> 6;
    const int wr = wave >> 1, wc = wave & 1, r = lane & 31, h = lane >> 5;
    const int kc = tid & 7, r0 = tid >> 3;
    u32x4 ar[4], br[4];
    const u16* ap = A + (size_t)r0 * lda + 8 * kc; const u16* bp = Bt + (size_t)r0 * ldb + 8 * kc;
#define GEMM_LOAD(KT) _Pragma("unroll") for (int i = 0; i < 4; ++i) { \
        ar[i] = *(const u32x4*)(ap + (size_t)(32 * i) * lda + 64 * (KT)); br[i] = *(const u32x4*)(bp + (size_t)(32 * i) * ldb + 64 * (KT)); }
#define GEMM_STORE(BUF) _Pragma("unroll") for (int i = 0; i < 4; ++i) { \
        *(u32x4*)(S0 + (BUF) * GEMM_STAGE + (r0 + 32 * i) * LDT + 8 * kc) = ar[i]; \
        *(u32x4*)(S0 + (BUF) * GEMM_STAGE + 128 * LDT + (r0 + 32 * i) * LDT + 8 * kc) = br[i]; }
    GEMM_LOAD(0)
    __syncthreads();
    GEMM_STORE(0)
    if (nk > 1) { GEMM_LOAD(1) }
#pragma unroll 1
    for (int kt = 0; kt < nk; ++kt) {
        __syncthreads();
        const int cur = kt & 1;
        if (kt + 1 < nk) { GEMM_STORE(cur ^ 1) }
        if (kt + 2 < nk) { GEMM_LOAD(kt + 2) }
        gemm_compute_tile(acc, S0 + cur * GEMM_STAGE, S0 + cur * GEMM_STAGE + 128 * LDT, wr, wc, r, h);
    }
}

constexpr int LDT2 = 136;
DI void gemm_bf16A_k128(f32x16 (&acc)[2][2], const u16* __restrict__ A, int lda, const u16* __restrict__ Bt, int ldb, int nk, char* smem) {
    u16* As = (u16*)smem; u16* Bs = As + 128 * LDT2;
    const int tid = threadIdx.x, lane = tid & 63, wave = tid >> 6;
    const int wr = wave >> 1, wc = wave & 1, r = lane & 31, h = lane >> 5;
    const int kc = tid & 15, r0 = tid >> 4;
    u32x4 ar[8], br[8];
    const u16* ap = A + (size_t)r0 * lda + 8 * kc; const u16* bp = Bt + (size_t)r0 * ldb + 8 * kc;
#pragma unroll
    for (int i = 0; i < 8; ++i) { ar[i] = *(const u32x4*)(ap + (size_t)(16 * i) * lda); br[i] = *(const u32x4*)(bp + (size_t)(16 * i) * ldb); }
#pragma unroll 1
    for (int kt = 0; kt < nk; ++kt) {
        __syncthreads();
#pragma unroll
        for (int i = 0; i < 8; ++i) {
            *(u32x4*)(As + (r0 + 16 * i) * LDT2 + 8 * kc) = ar[i];
            *(u32x4*)(Bs + (r0 + 16 * i) * LDT2 + 8 * kc) = br[i];
        }
        __syncthreads();
        if (kt + 1 < nk) {
#pragma unroll
            for (int i = 0; i < 8; ++i) {
                ar[i] = *(const u32x4*)(ap + (size_t)(16 * i) * lda + 128 * (kt + 1));
                br[i] = *(const u32x4*)(bp + (size_t)(16 * i) * ldb + 128 * (kt + 1));
            }
        }
#pragma unroll
        for (int ks = 0; ks < 8; ++ks) {
            const bf16x8 a0 = *(const bf16x8*)(As + (wr * 64 + r) * LDT2 + ks * 16 + 8 * h);
            const bf16x8 a1 = *(const bf16x8*)(As + (wr * 64 + 32 + r) * LDT2 + ks * 16 + 8 * h);
            const bf16x8 b0 = *(const bf16x8*)(Bs + (wc * 64 + r) * LDT2 + ks * 16 + 8 * h);
            const bf16x8 b1 = *(const bf16x8*)(Bs + (wc * 64 + 32 + r) * LDT2 + ks * 16 + 8 * h);
            acc[0][0] = MFMA32(a0, b0, acc[0][0]); acc[0][1] = MFMA32(a0, b1, acc[0][1]);
            acc[1][0] = MFMA32(a1, b0, acc[1][0]); acc[1][1] = MFMA32(a1, b1, acc[1][1]);
        }
    }
}
DI void gemm_bf16A_256(f32x16 (&acc)[2][2][2], const u16* __restrict__ A, int lda, const u16* __restrict__ Bt, int ldb, int nk, char* smem) {
    u16* As = (u16*)smem; u16* Bs = As + 256 * LDT;
    const int tid = threadIdx.x, lane = tid & 63, wave = tid >> 6;
    const int wr = wave >> 1, wc = wave & 1, r = lane & 31, h = lane >> 5;
    const int kc = tid & 7, r0 = tid >> 3;
    u32x4 ar[8], br[4];
    const u16* ap = A + (size_t)r0 * lda + 8 * kc; const u16* bp = Bt + (size_t)r0 * ldb + 8 * kc;
#pragma unroll
    for (int i = 0; i < 8; ++i) ar[i] = *(const u32x4*)(ap + (size_t)(32 * i) * lda);
#pragma unroll
    for (int i = 0; i < 4; ++i) br[i] = *(const u32x4*)(bp + (size_t)(32 * i) * ldb);
#pragma unroll 1
    for (int kt = 0; kt < nk; ++kt) {
        __syncthreads();
#pragma unroll
        for (int i = 0; i < 8; ++i) *(u32x4*)(As + (r0 + 32 * i) * LDT + 8 * kc) = ar[i];
#pragma unroll
        for (int i = 0; i < 4; ++i) *(u32x4*)(Bs + (r0 + 32 * i) * LDT + 8 * kc) = br[i];
        __syncthreads();
        if (kt + 1 < nk) {
#pragma unroll
            for (int i = 0; i < 8; ++i) ar[i] = *(const u32x4*)(ap + (size_t)(32 * i) * lda + 64 * (kt + 1));
#pragma unroll
            for (int i = 0; i < 4; ++i) br[i] = *(const u32x4*)(bp + (size_t)(32 * i) * ldb + 64 * (kt + 1));
        }
#pragma unroll
        for (int ks = 0; ks < 4; ++ks) {
            const bf16x8 b0 = *(const bf16x8*)(Bs + (wc * 64 + r) * LDT + ks * 16 + 8 * h);
            const bf16x8 b1 = *(const bf16x8*)(Bs + (wc * 64 + 32 + r) * LDT + ks * 16 + 8 * h);
#pragma unroll
            for (int hf = 0; hf < 2; ++hf) {
                const bf16x8 a0 = *(const bf16x8*)(As + (hf * 128 + wr * 64 + r) * LDT + ks * 16 + 8 * h);
                const bf16x8 a1 = *(const bf16x8*)(As + (hf * 128 + wr * 64 + 32 + r) * LDT + ks * 16 + 8 * h);
                acc[hf][0][0] = MFMA32(a0, b0, acc[hf][0][0]); acc[hf][0][1] = MFMA32(a0, b1, acc[hf][0][1]);
                acc[hf][1][0] = MFMA32(a1, b0, acc[hf][1][0]); acc[hf][1][1] = MFMA32(a1, b1, acc[hf][1][1]);
            }
        }
    }
}
DI bool xcd_tile256(int bid, int nb, int rnd, int NT, int& mt, int& nt) {
    if (nb & 7) { const int it = bid + rnd * nb; if (it >= 64 * NT) return false; mt = it / NT; nt = it - mt * NT; return true; }
    const int x = bid & 7, j = bid >> 3, per = nb >> 3;
    const int t = rnd * per + j;
    if (t >= 8 * NT) return false;
    nt = t >> 3; mt = x * 8 + (t & 7);
    return true;
}
DI void gemm_f32A(f32x16 (&acc)[2][2], const float* __restrict__ X, const float (&rs)[8], const float* __restrict__ g,
                  const float* __restrict__ scale, const float* __restrict__ shift, const u16* __restrict__ Bt, char* smem) {
    u16* As = (u16*)smem; u16* Bs = As + 128 * LDT;
    const int tid = threadIdx.x, lane = tid & 63, wave = tid >> 6;
    const int wr = wave >> 1, wc = wave & 1, r = lane & 31, h = lane >> 5;
    const int kcA = tid & 15, rA = tid >> 4;
    const int kc = tid & 7, r0 = tid >> 3;
    f32x4 xr[8]; u32x4 br[4]; f32x4 gm, sh;
#pragma unroll
    for (int i = 0; i < 8; ++i) xr[i] = *(const f32x4*)(X + (size_t)(rA + 16 * i) * DM + 4 * kcA);
#pragma unroll
    for (int i = 0; i < 4; ++i) br[i] = *(const u32x4*)(Bt + (size_t)(r0 + 32 * i) * DM + 8 * kc);
    {
        const f32x4 gg = *(const f32x4*)(g + 4 * kcA), ss = *(const f32x4*)(scale + 4 * kcA);
        sh = *(const f32x4*)(shift + 4 * kcA);
        gm.x = gg.x * (1.f + ss.x); gm.y = gg.y * (1.f + ss.y); gm.z = gg.z * (1.f + ss.z); gm.w = gg.w * (1.f + ss.w);
    }
    for (int kt = 0; kt < 16; ++kt) {
        __syncthreads();
#pragma unroll
        for (int i = 0; i < 8; ++i) {
            const float s = rs[i];
            u32x2 o;
            o.x = pack2(xr[i].x * s * gm.x + sh.x, xr[i].y * s * gm.y + sh.y);
            o.y = pack2(xr[i].z * s * gm.z + sh.z, xr[i].w * s * gm.w + sh.w);
            *(u32x2*)(As + (rA + 16 * i) * LDT + 4 * kcA) = o;
        }
#pragma unroll
        for (int i = 0; i < 4; ++i) *(u32x4*)(Bs + (r0 + 32 * i) * LDT + 8 * kc) = br[i];
        __syncthreads();
        if (kt + 1 < 16) {
            const int k0 = 64 * (kt + 1);
#pragma unroll
            for (int i = 0; i < 8; ++i) xr[i] = *(const f32x4*)(X + (size_t)(rA + 16 * i) * DM + k0 + 4 * kcA);
#pragma unroll
            for (int i = 0; i < 4; ++i) br[i] = *(const u32x4*)(Bt + (size_t)(r0 + 32 * i) * DM + k0 + 8 * kc);
            const f32x4 gg = *(const f32x4*)(g + k0 + 4 * kcA), ss = *(const f32x4*)(scale + k0 + 4 * kcA);
            sh = *(const f32x4*)(shift + k0 + 4 * kcA);
            gm.x = gg.x * (1.f + ss.x); gm.y = gg.y * (1.f + ss.y); gm.z = gg.z * (1.f + ss.z); gm.w = gg.w * (1.f + ss.w);
        }
        gemm_compute_tile(acc, As, Bs, wr, wc, r, h);
    }
}
DI void zero_acc(f32x16 (&acc)[2][2]) {
#pragma unroll
    for (int a = 0; a < 2; ++a)
#pragma unroll
        for (int b = 0; b < 2; ++b)
#pragma unroll
            for (int i = 0; i < 16; ++i) acc[a][b][i] = 0.f;
}


constexpr int LDO = 136;
DI float half_total(float x, int h) {
    x = row16_sum(x);
    x += dppm<0x142, 0xa>(x);
    const float s0 = __builtin_bit_cast(float, __builtin_amdgcn_readlane(__builtin_bit_cast(int, x), 31));
    const float s1 = __builtin_bit_cast(float, __builtin_amdgcn_readlane(__builtin_bit_cast(int, x), 63));
    return h ? s1 : s0;
}
template <bool TRANSPOSE> DI void stage_tile_bf16(u16* Os, const f32x16 (&acc)[2][2], int wr, int wc, int r, int h) {
#pragma unroll
    for (int mi = 0; mi < 2; ++mi)
#pragma unroll
        for (int ni = 0; ni < 2; ++ni)
#pragma unroll
            for (int i = 0; i < 16; ++i) {
                const int row = wr * 64 + mi * 32 + (i & 3) + 8 * (i >> 2) + 4 * h, col = wc * 64 + ni * 32 + r;
                Os[TRANSPOSE ? (col * LDO + row) : (row * LDO + col)] = f2bf(acc[mi][ni][i]);
            }
}
DI void flush_tile_bf16(const u16* Os, u16* __restrict__ dst, size_t ld) {
    const int tid = threadIdx.x;
#pragma unroll
    for (int j = 0; j < 8; ++j) {
        const int id = tid + 256 * j, row = id >> 4, c16 = id & 15;
        const u32x4 v = *(const u32x4*)(Os + row * LDO + c16 * 8);
        *(u32x4*)(dst + (size_t)row * ld + c16 * 8) = v;
    }
}

DI void ph1a(const Params& p, int bid, int nb) {
    const int tid = threadIdx.x, lane = tid & 63, wave = tid >> 6;
    const float* mod = (const float*)(p.ws + OFF_MOD);
    u16* H1 = (u16*)(p.ws + OFF_H1);
    f32x4 nx[4];
    {
        const int row0 = bid * 4 + wave;
        if (row0 < NTOK) {
            const f32x4* xr = (const f32x4*)(p.x + (size_t)row0 * DM + 16 * lane);
#pragma unroll
            for (int q = 0; q < 4; ++q) nx[q] = xr[q];
        }
    }
    for (int row = bid * 4 + wave; row < NTOK; row += nb * 4) {
        const int b = row / SEQ;
        const f32x4* gp = (const f32x4*)(p.norm1_g + 16 * lane);
        const f32x4* scp = (const f32x4*)(mod + b * 6144 + 1024 + 16 * lane);
        const f32x4* shp = (const f32x4*)(mod + b * 6144 + 16 * lane);
        f32x4 xv[4];
        float ss = 0.f;
#pragma unroll
        for (int q = 0; q < 4; ++q) { xv[q] = nx[q]; ss += xv[q].x * xv[q].x + xv[q].y * xv[q].y + xv[q].z * xv[q].z + xv[q].w * xv[q].w; }
        if (row + nb * 4 < NTOK) {
            const f32x4* xr = (const f32x4*)(p.x + (size_t)(row + nb * 4) * DM + 16 * lane);
#pragma unroll
            for (int q = 0; q < 4; ++q) nx[q] = xr[q];
        }
        ss = wave_sum(ss);
        const float rs = rsqrtf(ss * (1.f / 1024.f) + 1e-6f);
        unsigned o[8];
#pragma unroll
        for (int q = 0; q < 4; ++q) {
            const f32x4 g = gp[q], sc = scp[q], sh = shp[q];
            o[2 * q]     = pack2(xv[q].x * rs * g.x * (1.f + sc.x) + sh.x, xv[q].y * rs * g.y * (1.f + sc.y) + sh.y);
            o[2 * q + 1] = pack2(xv[q].z * rs * g.z * (1.f + sc.z) + sh.z, xv[q].w * rs * g.w * (1.f + sc.w) + sh.w);
        }
        u32x4* dst = (u32x4*)(H1 + (size_t)row * DM + 16 * lane);
        dst[0] = (u32x4){o[0], o[1], o[2], o[3]}; dst[1] = (u32x4){o[4], o[5], o[6], o[7]};
    }
    const u16* WQT = (const u16*)(p.ws + OFF_WQT);
    float* SW = (float*)(p.ws + OFF_SW);
    for (int n = bid * 4 + wave; n < 2048; n += nb * 4) {
        float w[16];
        load8(WQT + (size_t)n * DM + 16 * lane, *(float(*)[8])&w[0]);
        load8(WQT + (size_t)n * DM + 16 * lane + 8, *(float(*)[8])&w[8]);
#pragma unroll 1
        for (int b = 0; b < 8; ++b) {
            const f32x4* shp = (const f32x4*)(mod + b * 6144 + 3072 + 16 * lane);
            float sacc = 0.f;
#pragma unroll
            for (int q = 0; q < 4; ++q) { const f32x4 sh = shp[q]; sacc += sh.x * w[4 * q] + sh.y * w[4 * q + 1] + sh.z * w[4 * q + 2] + sh.w * w[4 * q + 3]; }
            sacc = wave_sum(sacc);
            if (lane == 0) SW[b * 2048 + n] = sacc;
        }
    }
}

DI void ph1(const Params& p, char* smem, int bid, int nb) {
    const int tid = threadIdx.x, lane = tid & 63, wave = tid >> 6;
    const int wr = wave >> 1, wc = wave & 1, r = lane & 31, h = lane >> 5;
    const u16* H1 = (const u16*)(p.ws + OFF_H1);
    const u16* WT = (const u16*)(p.ws + OFF_WINT);
    u16* QK = (u16*)((char*)p.out + OUT_QK); u16* VT = (u16*)((char*)p.out + OUT_VT);
    u16* PRW = (u16*)(p.ws + OFF_PRW);
    int mt, nt;
    for (int rnd = 0; xcd_tile(bid, nb, rnd, 27, mt, nt); ++rnd) {
        const int m0 = mt * 128, n0 = nt * 128, b = m0 / SEQ;
        f32x16 acc[2][2]; zero_acc(acc);
        gemm_bf16A_k128(acc, H1 + (size_t)m0 * DM, DM, WT + (size_t)n0 * DM, DM, 8, smem);
        u16* Os = (u16*)smem;
        if (nt < 8) {
            const float* gv = (nt < 4) ? p.qn_g : p.kn_g;
            const float mul = (nt < 4) ? 0.125f * LOG2E : 1.f;
            const float g0 = gv[r] * mul, g1 = gv[32 + r] * mul;
#pragma unroll
            for (int mi = 0; mi < 2; ++mi)
#pragma unroll
                for (int i = 0; i < 16; ++i) {
                    const float v0 = acc[mi][0][i], v1 = acc[mi][1][i];
                    const float ss = half_total(v0 * v0 + v1 * v1, h);
                    const float rn = rsqrtf(ss * (1.f / 64.f) + 1e-6f);
                    acc[mi][0][i] = v0 * rn * g0; acc[mi][1][i] = v1 * rn * g1;
                }
        }
        __syncthreads();
        if (nt >= 8 && nt < 12) stage_tile_bf16<true>(Os, acc, wr, wc, r, h);
        else stage_tile_bf16<false>(Os, acc, wr, wc, r, h);
        __syncthreads();
        if (nt < 8) flush_tile_bf16(Os, QK + (size_t)m0 * 1024 + n0, 1024);
        else if (nt < 12) flush_tile_bf16(Os, VT + ((size_t)(b * 4 + (nt - 8)) * 128) * SEQ + (m0 % SEQ), SEQ);
        else flush_tile_bf16(Os, PRW + (size_t)m0 * RWC + (n0 - 1536), RWC);
    }
}

DI void shifted8(const u16* PRW, const float* mu, int tok, int c, float (&o)[8]) {
    const int t = tok % SEQ;
    float cur[8], prv[8], nxt[8];
    load8(PRW + (size_t)tok * RWC + c, cur);
    if (t > 0) load8(PRW + (size_t)(tok - 1) * RWC + c, prv); else {
#pragma unroll
        for (int j = 0; j < 8; ++j) prv[j] = 0.f; }
    if (t < SEQ - 1) load8(PRW + (size_t)(tok + 1) * RWC + c, nxt); else {
#pragma unroll
        for (int j = 0; j < 8; ++j) nxt[j] = 0.f; }
    const f32x4 m0a = *(const f32x4*)(mu + c), m0b = *(const f32x4*)(mu + c + 4);
    const f32x4 m1a = *(const f32x4*)(mu + RWC + c), m1b = *(const f32x4*)(mu + RWC + c + 4);
    const float m0[8] = {m0a.x, m0a.y, m0a.z, m0a.w, m0b.x, m0b.y, m0b.z, m0b.w};
    const float m1[8] = {m1a.x, m1a.y, m1a.z, m1a.w, m1b.x, m1b.y, m1b.z, m1b.w};
#pragma unroll
    for (int j = 0; j < 8; ++j) o[j] = cur[j] + m0[j] * (prv[j] - cur[j]) + m1[j] * (nxt[j] - cur[j]);
}
DI void shifted8c(const u16* PRW, const float (&m0)[8], const float (&m1)[8], int tok, int c, float (&o)[8]) {
    const int t = tok % SEQ;
    float cur[8], prv[8], nxt[8];
    load8(PRW + (size_t)tok * RWC + c, cur);
    if (t > 0) load8(PRW + (size_t)(tok - 1) * RWC + c, prv); else {
#pragma unroll
        for (int j = 0; j < 8; ++j) prv[j] = 0.f; }
    if (t < SEQ - 1) load8(PRW + (size_t)(tok + 1) * RWC + c, nxt); else {
#pragma unroll
        for (int j = 0; j < 8; ++j) nxt[j] = 0.f; }
#pragma unroll
    for (int j = 0; j < 8; ++j) o[j] = cur[j] + m0[j] * (prv[j] - cur[j]) + m1[j] * (nxt[j] - cur[j]);
}
DI void load8f(const float* ptr, float (&o)[8]) {
    const f32x4 a = *(const f32x4*)ptr, b = *(const f32x4*)(ptr + 4);
    o[0] = a.x; o[1] = a.y; o[2] = a.z; o[3] = a.w; o[4] = b.x; o[5] = b.y; o[6] = b.z; o[7] = b.w;
}
DI void ph2a(const Params& p, int bid, int nb) {
    const u16* PRW = (const u16*)(p.ws + OFF_PRW);
    u16* RS = (u16*)(p.ws + OFF_RS); u16* KS = (u16*)(p.ws + OFF_KS); u16* VS = (u16*)(p.ws + OFF_VS);
    u16* BON = (u16*)(p.ws + OFF_BONUS); float* INVN = (float*)(p.ws + OFF_INVN);
    const int c = (threadIdx.x & 63) * 8, hd = c >> 6;
    float mr0[8], mr1[8], mk0[8], mk1[8], mv0[8], mv1[8], kkv[8], rkv[8];
    load8f(p.mu + c, mr0); load8f(p.mu + RWC + c, mr1);
    load8f(p.mu + 512 + c, mk0); load8f(p.mu + RWC + 512 + c, mk1);
    load8f(p.mu + 1024 + c, mv0); load8f(p.mu + RWC + 1024 + c, mv1);
    load8f(p.k_k + c, kkv); load8f(p.r_k + c, rkv);
    for (int e = bid * 256 + threadIdx.x; e < NTOK * 64; e += nb * 256) {
        const int tok = e >> 6;
        float rr[8], kk[8], vv[8];
        shifted8c(PRW, mr0, mr1, tok, c, rr);
        shifted8c(PRW, mk0, mk1, tok, 512 + c, kk);
        shifted8c(PRW, mv0, mv1, tok, 1024 + c, vv);
        float ssq = 0.f, rkr = 0.f;
#pragma unroll
        for (int j = 0; j < 8; ++j) { const float t = kk[j] * kkv[j]; ssq += t * t; rkr += rr[j] * kk[j] * rkv[j]; }
        ssq = grp8_sum(ssq); rkr = grp8_sum(rkr);
        store8(RS + (size_t)tok * 512 + c, rr); store8(KS + (size_t)tok * 512 + c, kk); store8(VS + (size_t)tok * 512 + c, vv);
        float bo[8];
#pragma unroll
        for (int j = 0; j < 8; ++j) bo[j] = rkr * vv[j];
        store8(BON + (size_t)tok * 512 + c, bo);
        if ((e & 7) == 0) INVN[tok * 8 + hd] = 1.f / fmaxf(sqrtf(ssq), 1e-12f);
    }
}

constexpr int LDP = 136;
DI void ph2b(const Params& p, char* smem, int bid, int nb) {
    const int tid = threadIdx.x, lane = tid & 63, wave = tid >> 6, r = lane & 31, h = lane >> 5;
    u16* TW = (u16*)smem; u16* AD = TW + 32 * LDP; u16* SG = AD + 32 * LDP;
    const u16* PRW = (const u16*)(p.ws + OFF_PRW);
    const u16* W2T = (const u16*)(p.ws + OFF_W2T); const u16* A2T = (const u16*)(p.ws + OFF_A2T); const u16* G2T = (const u16*)(p.ws + OFF_G2T);
    u16* DEC = (u16*)(p.ws + OFF_DEC); u16* AA = (u16*)(p.ws + OFF_AA); u16* G = (u16*)(p.ws + OFF_G);
    for (int it = bid; it < NTOK / 32; it += nb) {
        const int tok0 = it * 32;
        __syncthreads();
        for (int e = tid; e < 32 * 48; e += 256) {
            const int tl = e / 48, c8 = (e % 48) * 8;
            float v[8];
            shifted8(PRW, p.mu, tok0 + tl, 1536 + c8, v);
            if (c8 < 128) {
#pragma unroll
                for (int j = 0; j < 8; ++j) v[j] = tanhf(v[j]);
                store8(TW + tl * LDP + c8, v);
            } else if (c8 < 256) {
                store8(AD + tl * LDP + (c8 - 128), v);
            } else {
#pragma unroll
                for (int j = 0; j < 8; ++j) v[j] = sigmoidf_(v[j]);
                store8(SG + tl * LDP + (c8 - 256), v);
            }
        }
        __syncthreads();
        bf16x8 bcur[8], bnxt[8];
#define P2_LOADB(DST, IT) { const int g_ = (IT) >> 2, n_ = wave * 128 + ((IT) & 3) * 32 + r, d_ = g_ & 1; \
            const u16* bs_ = (g_ < 2) ? W2T + (size_t)d_ * 512 * 64 : (g_ < 4 ? A2T + (size_t)d_ * 512 * 64 : G2T); \
            const int ldb_ = (g_ < 4) ? 64 : 128; \
            _Pragma("unroll") for (int ks = 0; ks < 4; ++ks) DST[ks] = *(const bf16x8*)(bs_ + (size_t)n_ * ldb_ + ks * 16 + 8 * h); \
            if (g_ == 4) { _Pragma("unroll") for (int ks = 4; ks < 8; ++ks) DST[ks] = *(const bf16x8*)(bs_ + (size_t)n_ * ldb_ + ks * 16 + 8 * h); } }
        P2_LOADB(bcur, 0)
#pragma unroll 1
        for (int it = 0; it < 20; ++it) {
            const int gsel = it >> 2, ni = it & 3, dir = gsel & 1;
            const u16* Asrc = (gsel < 2) ? TW : (gsel < 4 ? AD : SG);
            const int acol = (gsel < 4) ? dir * 64 : 0;
            const int n = wave * 128 + ni * 32 + r;
            if (it + 1 < 20) P2_LOADB(bnxt, it + 1)
            f32x16 acc0;
#pragma unroll
            for (int i = 0; i < 16; ++i) acc0[i] = 0.f;
#pragma unroll
            for (int ks = 0; ks < 4; ++ks) {
                const bf16x8 a0 = *(const bf16x8*)(Asrc + r * LDP + acol + ks * 16 + 8 * h);
                acc0 = MFMA32(a0, bcur[ks], acc0);
            }
            if (gsel == 4) {
#pragma unroll
                for (int ks = 4; ks < 8; ++ks) {
                    const bf16x8 a0 = *(const bf16x8*)(Asrc + r * LDP + acol + ks * 16 + 8 * h);
                    acc0 = MFMA32(a0, bcur[ks], acc0);
                }
            }
            if (gsel < 2) {
                const float w0v = p.w0[dir * 512 + n];
#pragma unroll
                for (int i = 0; i < 16; ++i) {
                    const float pre = w0v + acc0[i];
                    const float z = -pre;
                    const float sp = fmaxf(z, 0.f) + __logf(1.f + __expf(-fabsf(z)));
                    const float w = -sp - 0.5f;
                    const float dec = __expf(-__expf(w));
                    DEC[((size_t)dir * NTOK + tok0 + crow(i, h)) * 512 + n] = f2bf(1.f - dec);
                }
            } else if (gsel < 4) {
                const float a0v = p.a0[dir * 512 + n];
#pragma unroll
                for (int i = 0; i < 16; ++i) {
                    const float a = sigmoidf_(a0v + acc0[i]);
                    AA[((size_t)dir * NTOK + tok0 + crow(i, h)) * 512 + n] = f2bf(a);
                }
            } else {
#pragma unroll
                for (int i = 0; i < 16; ++i)
                    G[(size_t)(tok0 + crow(i, h)) * 512 + n] = f2bf(acc0[i]);
            }
#pragma unroll
            for (int ks = 0; ks < 8; ++ks) bcur[ks] = bnxt[ks];
        }
    }
}

constexpr int LDK = 136, LDV = 68, ATT_STAGE = 64 * LDK + 128 * LDV;
DI void ph2c(const Params& p, char* smem, int bid, int nb) {
    const int tid = threadIdx.x, lane = tid & 63, wave = tid >> 6, r = lane & 31, h = lane >> 5;
    const int qg = wave >> 1, c = wave & 1;
    u16* Kt = (u16*)smem; u16* Vs = Kt + 64 * LDK;
    float* exch = (float*)smem;
    u16* QK = (u16*)((char*)p.out + OUT_QK); const u16* VT = (const u16*)((char*)p.out + OUT_VT);
    float lam, M2;
    {
        const float l0 = p.da_lambda[lane], l1 = p.da_lambda[64 + lane], l2 = p.da_lambda[128 + lane], l3 = p.da_lambda[192 + lane];
        const float s1 = wave_sum(l0 * l1), s2 = wave_sum(l2 * l3);
        lam = __expf(s1) - __expf(s2) + 0.2f;
        const float mq = wave_max(fabsf(p.qn_g[lane])), mk = wave_max(fabsf(p.kn_g[lane]));
        M2 = 8.f * mq * mk * LOG2E;
    }
    for (int it = bid; it < NB * 4 * 32; it += nb) {
        const int qt = it & 31, hd = (it >> 5) & 3, b = it >> 7;
        const int q0 = qt * 64 + qg * 32;
        const float slope2 = exp2f(-2.f * (hd + 1)) * LOG2E;
        bf16x8 qfr[4];
        {
            const u16* qp = QK + (size_t)(b * SEQ + q0 + r) * 1024 + hd * 128 + c * 64 + 8 * h;
#pragma unroll
            for (int ks = 0; ks < 4; ++ks) qfr[ks] = *(const bf16x8*)(qp + ks * 16);
        }
        const u16* kg = QK + (size_t)(b * SEQ) * 1024 + 512 + hd * 128;
        const u16* vg = VT + (size_t)(b * 4 + hd) * 128 * SEQ;
        u32x4 kreg[4], vreg[4];
        const unsigned koff = (unsigned)((tid >> 4) * 2048 + (tid & 15) * 16), voff = (unsigned)((tid >> 3) * (SEQ * 2) + (tid & 7) * 16);
#define ATT_LOAD(KT) { const char* kb_ = (const char*)(kg + (size_t)(KT) * 64 * 1024); const char* vb_ = (const char*)(vg + (KT) * 64); \
            _Pragma("unroll") for (int j = 0; j < 4; ++j) { \
            kreg[j] = *(const u32x4*)(kb_ + (koff + (unsigned)j * 32768u)); \
            vreg[j] = *(const u32x4*)(vb_ + (voff + (unsigned)j * (32u * SEQ * 2u))); } }
#define ATT_STORE(BUF) _Pragma("unroll") for (int j = 0; j < 4; ++j) { const int id = tid + 256 * j; \
            *(u32x4*)(Kt + (BUF) * ATT_STAGE + (id >> 4) * LDK + (id & 15) * 8) = kreg[j]; \
            u32x2* d = (u32x2*)(Vs + (BUF) * ATT_STAGE + (id >> 3) * LDV + (id & 7) * 8); \
            d[0] = (u32x2){vreg[j].x, vreg[j].y}; d[1] = (u32x2){vreg[j].z, vreg[j].w}; }
        ATT_LOAD(0)
        __syncthreads();
        ATT_STORE(0)
        ATT_LOAD(1)
        f32x16 O[4];
#pragma unroll
        for (int dt = 0; dt < 4; ++dt)
#pragma unroll
            for (int i = 0; i < 16; ++i) O[dt][i] = 0.f;
        float lsum = 0.f;
#pragma unroll 1
        for (int kt = 0; kt < SEQ / 64; ++kt) {
            __syncthreads();
            const int cur = kt & 1;
            if (kt + 1 < SEQ / 64) { ATT_STORE(cur ^ 1) }
            if (kt + 2 < SEQ / 64) { ATT_LOAD(kt + 2) }
            const u16* Kc = Kt + cur * ATT_STAGE; const u16* Vc = Vs + cur * ATT_STAGE;
#pragma unroll
            for (int sub = 0; sub < 2; ++sub) {
                const int k0 = kt * 64 + sub * 32;
                const float fd0 = (float)(q0 + r - (k0 + 4 * h));
                const bool diag = (k0 == q0 - (q0 & 31));
                const float ss = (q0 > k0) ? slope2 : -slope2;
                f32x16 S;
                if (diag) {
#pragma unroll
                    for (int i = 0; i < 16; ++i) S[i] = -M2;
                } else {
                    const float A = __builtin_fmaf(-ss, fd0, -M2);
#pragma unroll
                    for (int i = 0; i < 16; ++i) S[i] = __builtin_fmaf(ss, (float)((i & 3) + 8 * (i >> 2)), A);
                }
#pragma unroll
                for (int ks = 0; ks < 4; ++ks) {
                    const bf16x8 kf = *(const bf16x8*)(Kc + (sub * 32 + r) * LDK + c * 64 + ks * 16 + 8 * h);
                    S = MFMA32(kf, qfr[ks], S);
                }
                float pv[16];
                if (diag) {
#pragma unroll
                    for (int i = 0; i < 16; ++i) {
                        const float t = fd0 - (float)((i & 3) + 8 * (i >> 2));
                        pv[i] = __builtin_amdgcn_exp2f(S[i] - slope2 * fabsf(t));
                    }
                } else {
#pragma unroll
                    for (int i = 0; i < 16; ++i) pv[i] = __builtin_amdgcn_exp2f(S[i]);
                }
#pragma unroll
                for (int i = 0; i < 16; ++i) lsum += pv[i];
                bf16x8 pa[2];
#pragma unroll
                for (int s = 0; s < 2; ++s) {
                    u32x4 cv;
#pragma unroll
                    for (int j = 0; j < 4; ++j) cv[j] = pack2(pv[8 * s + 2 * j], pv[8 * s + 2 * j + 1]);
                    pa[s] = __builtin_bit_cast(bf16x8, cv);
                }
#pragma unroll
                for (int s = 0; s < 2; ++s)
#pragma unroll
                    for (int dt = 0; dt < 4; ++dt) {
                        const u16* vp = Vc + (dt * 32 + r) * LDV + sub * 32 + 16 * s + 4 * h;
                        const u32x2 vlo = *(const u32x2*)(vp), vhi = *(const u32x2*)(vp + 8);
                        const bf16x8 vb = __builtin_bit_cast(bf16x8, (u32x4){vlo.x, vlo.y, vhi.x, vhi.y});
                        O[dt] = MFMA32(pa[s], vb, O[dt]);
                    }
            }
        }
        lsum += __shfl_xor(lsum, 32);
        const float il = (c == 0) ? 1.f / lsum : lam / lsum;
#pragma unroll
        for (int i = 0; i < 16; ++i) {
            const float a = __shfl(il, crow(i, h));
#pragma unroll
            for (int dt = 0; dt < 4; ++dt) O[dt][i] *= a;
        }
        __syncthreads();
        if (c == 1) {
#pragma unroll
            for (int dt = 0; dt < 4; ++dt)
#pragma unroll
                for (int i = 0; i < 16; ++i) exch[((qg * 4 + dt) * 16 + i) * 64 + lane] = O[dt][i];
        }
        __syncthreads();
        if (c == 0) {
            float gsub[4];
#pragma unroll
            for (int dt = 0; dt < 4; ++dt) gsub[dt] = p.subln_g[dt * 32 + r] * 0.8f;
#pragma unroll
            for (int i = 0; i < 16; ++i) {
                float o[4], ss = 0.f;
#pragma unroll
                for (int dt = 0; dt < 4; ++dt) { o[dt] = O[dt][i] - exch[((qg * 4 + dt) * 16 + i) * 64 + lane]; ss += o[dt] * o[dt]; }
                ss = half_sum(ss);
                const float rn = rsqrtf(ss * (1.f / 128.f) + 1e-6f);
                u16* dst = (u16*)((char*)p.out + OUT_ATT) + (size_t)(b * SEQ + q0 + crow(i, h)) * 512 + hd * 128 + r;
#pragma unroll
                for (int dt = 0; dt < 4; ++dt) dst[dt * 32] = f2bf(o[dt] * rn * gsub[dt]);
            }
        }
    }
}

struct ScanBuf { float kk[16][64], dec[16][64], bb[16][64], kd[16][64], rr[16][64], vv[16][16]; };
struct ScanRegs { u32x2 rs, ks, aa; f32x4 dec; float invn; u16 v; };
DI void scan_load(ScanRegs& g, const Params& p, int b, int hd, int dir, int rg, int chunk) {
    const int tid = threadIdx.x, s = tid >> 4, kq = tid & 15;
    const int t = dir ? (SEQ - 1 - (chunk * 16 + s)) : (chunk * 16 + s);
    const size_t tok = (size_t)b * SEQ + t;
    const size_t off = tok * 512 + hd * 64 + 4 * kq;
    g.rs = *(const u32x2*)((const u16*)(p.ws + OFF_RS) + off);
    g.ks = *(const u32x2*)((const u16*)(p.ws + OFF_KS) + off);
    g.aa = *(const u32x2*)((const u16*)(p.ws + OFF_AA) + (size_t)dir * NTOK * 512 + off);
    g.dec = *(const f32x4*)((const float*)(p.ws + OFF_DEC) + (size_t)dir * NTOK * 512 + off);
    g.invn = ((const float*)(p.ws + OFF_INVN))[tok * 8 + hd];
    g.v = ((const u16*)(p.ws + OFF_VS))[tok * 512 + hd * 64 + rg * 16 + kq];
}
DI void scan_store(const ScanRegs& g, ScanBuf* sb, const f32x4& kkc, const f32x4& kac) {
    const int tid = threadIdx.x, s = tid >> 4, kq = tid & 15;
    const float k0 = bflo(g.ks.x), k1 = bfhi(g.ks.x), k2 = bflo(g.ks.y), k3 = bfhi(g.ks.y);
    const float a0 = bflo(g.aa.x), a1 = bfhi(g.aa.x), a2 = bflo(g.aa.y), a3 = bfhi(g.aa.y);
    f32x4 kk, bb, kd, rr;
    kk.x = k0 * kkc.x * g.invn; kk.y = k1 * kkc.y * g.invn; kk.z = k2 * kkc.z * g.invn; kk.w = k3 * kkc.w * g.invn;
    bb.x = kk.x * a0; bb.y = kk.y * a1; bb.z = kk.z * a2; bb.w = kk.w * a3;
    kd.x = k0 * (1.f + (a0 - 1.f) * kac.x); kd.y = k1 * (1.f + (a1 - 1.f) * kac.y);
    kd.z = k2 * (1.f + (a2 - 1.f) * kac.z); kd.w = k3 * (1.f + (a3 - 1.f) * kac.w);
    rr.x = bflo(g.rs.x); rr.y = bfhi(g.rs.x); rr.z = bflo(g.rs.y); rr.w = bfhi(g.rs.y);
    *(f32x4*)&sb->kk[s][4 * kq] = kk; *(f32x4*)&sb->dec[s][4 * kq] = g.dec; *(f32x4*)&sb->bb[s][4 * kq] = bb;
    *(f32x4*)&sb->kd[s][4 * kq] = kd; *(f32x4*)&sb->rr[s][4 * kq] = rr;
    sb->vv[s][kq] = bf2f(g.v);
}
DI void ph3(const Params& p, char* smem, int bid, int nb) {
    const int tid = threadIdx.x, lane = tid & 63, wave = tid >> 6;
    ScanBuf* sb = (ScanBuf*)smem;
    const int rl = lane >> 4, kq = lane & 15, row = wave * 4 + rl;
    for (int it = bid; it < 512; it += nb) {
        const int rg = it & 3, chain = it >> 2, dir = chain & 1, hd = (chain >> 1) & 7, b = chain >> 4;
        const int ld_kq = tid & 15;
        const f32x4 kkc = *(const f32x4*)(p.k_k + hd * 64 + 4 * ld_kq), kac = *(const f32x4*)(p.k_a + hd * 64 + 4 * ld_kq);
        u16* Y = (u16*)(p.ws + (dir ? OFF_YB : OFF_YF));
        f32x4 st = {0.f, 0.f, 0.f, 0.f};
        ScanRegs g;
        __syncthreads();
        scan_load(g, p, b, hd, dir, rg, 0);
        scan_store(g, &sb[0], kkc, kac);
        __syncthreads();
        for (int ch = 0; ch < SEQ / 16; ++ch) {
            const ScanBuf* cur = &sb[ch & 1];
            if (ch + 1 < SEQ / 16) scan_load(g, p, b, hd, dir, rg, ch + 1);
            float ykeep = 0.f;
#pragma unroll
            for (int s = 0; s < 16; ++s) {
                const f32x4 kk = *(const f32x4*)&cur->kk[s][4 * kq];
                const f32x4 dc = *(const f32x4*)&cur->dec[s][4 * kq];
                const f32x4 bb = *(const f32x4*)&cur->bb[s][4 * kq];
                const f32x4 kd = *(const f32x4*)&cur->kd[s][4 * kq];
                const f32x4 rr = *(const f32x4*)&cur->rr[s][4 * kq];
                const float v = cur->vv[s][row];
                float yp = 0.f;
                if (dir) yp = add_(fma_(st.x, rr.x, mul_(st.y, rr.y)), fma_(st.z, rr.z, mul_(st.w, rr.w)));
                const float sa = -row16_sum(add_(fma_(st.x, kk.x, mul_(st.y, kk.y)), fma_(st.z, kk.z, mul_(st.w, kk.w))));
                st.x = fma_(sa, bb.x, fma_(st.x, dc.x, mul_(v, kd.x)));
                st.y = fma_(sa, bb.y, fma_(st.y, dc.y, mul_(v, kd.y)));
                st.z = fma_(sa, bb.z, fma_(st.z, dc.z, mul_(v, kd.z)));
                st.w = fma_(sa, bb.w, fma_(st.w, dc.w, mul_(v, kd.w)));
                if (!dir) yp = add_(fma_(st.x, rr.x, mul_(st.y, rr.y)), fma_(st.z, rr.z, mul_(st.w, rr.w)));
                const float y = row16_sum(yp);
                ykeep = (kq == s) ? y : ykeep;
            }
            if (ch + 1 < SEQ / 16) scan_store(g, &sb[(ch + 1) & 1], kkc, kac);
            {
                const int t = dir ? (SEQ - 1 - (ch * 16 + kq)) : (ch * 16 + kq);
                Y[((size_t)b * SEQ + t) * 512 + hd * 64 + rg * 16 + row] = f2bf(ykeep);
            }
            __syncthreads();
        }
    }
}

constexpr int C4_A1 = 0, C4_A1SZ = 5632;
constexpr int C4_SETB = 16896, C4_SETBSZ = 8448;
constexpr int C4_VT = 5120, C4_G16 = 8192;
constexpr int C4_LK = 50688, C4_LR = 55296, C4_LKSZ = 2304;
constexpr int C4_LBKR = 62208, C4_LBKRSZ = 4608;
constexpr int C4_M4 = 71424, C4_M4SZ = 4096;
constexpr int C4_TOTAL = 79616;
typedef int i32x4_t __attribute__((ext_vector_type(4)));
#define C4_COEF(V4, S, T) __builtin_bit_cast(float, __builtin_amdgcn_readlane(V4[(T) & 3], 4 * (S) + ((T) >> 2)))
#define C4_MU(T) (((T) & 3) + 8 * (((T) >> 2) & 1) + 4 * ((T) >> 3))
struct C4Raw { unsigned ks[16], rs[16], vs[16], aa[16], dc[16]; int inv; };
DI void c4_load_step(C4Raw& w, const Params& p, int dir, unsigned tokb, unsigned lane2, int j) {
    const char* RS = (const char*)(p.ws + OFF_RS); const char* KS = (const char*)(p.ws + OFF_KS); const char* VS = (const char*)(p.ws + OFF_VS);
    const char* AA = (const char*)(p.ws + OFF_AA + (size_t)dir * NTOK * 512 * 2);
    const char* DEC = (const char*)(p.ws + OFF_DEC + (size_t)dir * NTOK * 512 * 2);
    const unsigned o2 = tokb + lane2;
    w.ks[j] = *(const u16*)(KS + o2); w.rs[j] = *(const u16*)(RS + o2); w.vs[j] = *(const u16*)(VS + o2); w.aa[j] = *(const u16*)(AA + o2);
    w.dc[j] = *(const u16*)(DEC + o2);
}
DI unsigned c4_tokb0(int b, int hd, int dir, int c1) {
    return (unsigned)(b * SEQ + (dir ? (SEQ - 1 - 16 * c1) : 16 * c1)) * 1024u + (unsigned)(hd * 128);
}
DI int c4_load_inv(const Params& p, int b, int hd, int dir, int c1, int lane) {
    const int* INVN = (const int*)(p.ws + OFF_INVN);
    const int st = 16 * c1 + (lane & 15);
    const unsigned tok = (unsigned)(b * SEQ + (dir ? (SEQ - 1 - st) : st));
    return INVN[tok * 8u + (unsigned)hd];
}
DI void c4_x(C4Raw& w, const Params& p, char* smem, int cx, int b, int hd, int dir, int lane, float kkc, float kac) {
    asm volatile("" : "+v"(lane));
    u16* LK = (u16*)(smem + C4_LK + (cx & 1) * C4_LKSZ); u16* LR = (u16*)(smem + C4_LR + (cx % 3) * C4_LKSZ);
    u16* LBKR = (u16*)(smem + C4_LBKR + (cx & 1) * C4_LBKRSZ);
    char* setb = smem + C4_SETB + (cx & 3) * C4_SETBSZ;
    u16* LBKT = (u16*)setb; u16* VT = (u16*)(setb + C4_VT); float* G16 = (float*)(setb + C4_G16);
    const int cn = (cx + 1 < SEQ / 16) ? cx + 1 : cx;
    const int invv = w.inv;
    const int inv_next = c4_load_inv(p, b, hd, dir, cn, lane);
    const unsigned lane2 = 2u * (unsigned)lane;
    unsigned tb = c4_tokb0(b, hd, dir, cn);
    const unsigned tstep = dir ? (unsigned)-1024 : 1024u;
    float G = 1.f;
#pragma unroll
    for (int j = 0; j < 16; j += 2) {
        float nb_[2], kd_[2];
#pragma unroll
        for (int e = 0; e < 2; ++e) {
            const int s = j + e;
            asm volatile("" : "+v"(w.ks[s]), "+v"(w.aa[s]), "+v"(w.rs[s]), "+v"(w.vs[s]), "+v"(w.dc[s]) : "v"(G));
            const float kf = __uint_as_float(w.ks[s] << 16), af = __uint_as_float(w.aa[s] << 16), rf = __uint_as_float(w.rs[s] << 16);
            const float inv = __builtin_bit_cast(float, __builtin_amdgcn_readlane(invv, s));
            const float kkv = kf * kkc * inv;
            const float bbv = kkv * af;
            const float kdv = kf * __builtin_fmaf(af, kac, 1.f - kac);
            const float kt = kkv * G;
            const float Gb = G;
            G *= 1.f - __uint_as_float(w.dc[s] << 16);
            const float rsel = rf * (dir ? Gb : G);
            const float ig = __builtin_amdgcn_rcpf(G);
            float ig2 = ig; asm volatile("" : "+v"(ig2));
            const float bt = bbv * ig, kdt = kdv * ig2;
            const unsigned pkr = pack2(kt, rsel), pbk = pack2(bt, kdt);
            LK[s * 72 + lane] = (u16)pkr;
            LR[s * 72 + lane] = (u16)(pkr >> 16);
            LBKR[s * 72 + lane] = (u16)pbk;
            LBKR[(16 + s) * 72 + lane] = (u16)(pbk >> 16);
            nb_[e] = -bt; kd_[e] = kdt;
        }
        *(unsigned*)(LBKT + lane * 40 + j) = pack2(nb_[0], nb_[1]);
        *(unsigned*)(LBKT + lane * 40 + 16 + j) = pack2(kd_[0], kd_[1]);
        *(unsigned*)(VT + lane * 24 + j) = w.vs[j] | (w.vs[j + 1] << 16);
        c4_load_step(w, p, dir, tb, lane2, j); tb += tstep;
        c4_load_step(w, p, dir, tb, lane2, j + 1); tb += tstep;
    }
    G16[lane] = G;
    w.inv = inv_next;
}
DI void c4_y(char* smem, int cy, int dir, int lane) {
    asm volatile("" : "+v"(lane));
    const u16* LK = (const u16*)(smem + C4_LK + (cy & 1) * C4_LKSZ); const u16* LR = (const u16*)(smem + C4_LR + (cy % 3) * C4_LKSZ);
    const u16* LBKR = (const u16*)(smem + C4_LBKR + (cy & 1) * C4_LBKRSZ);
    float* M4 = (float*)(smem + C4_M4 + (cy & 1) * C4_M4SZ);
    u16* A1 = (u16*)(smem + C4_A1 + (cy % 3) * C4_A1SZ);
    const int r = lane & 31, h = lane >> 5;
    {
        f32x16 acc;
#pragma unroll
        for (int i = 0; i < 16; ++i) acc[i] = 0.f;
        const u16* brow = (r < 16) ? (LK + r * 72) : (LR + (r - 16) * 72);
#pragma unroll
        for (int ks = 0; ks < 4; ++ks) {
            const bf16x8 a = *(const bf16x8*)(LBKR + r * 72 + ks * 16 + 8 * h);
            const bf16x8 bq = *(const bf16x8*)(brow + ks * 16 + 8 * h);
            acc = MFMA32(a, bq, acc);
        }
        const int t = r & 15, lim = t + (((r >> 4) & (dir ^ 1)));
        float* dst = M4 + (r >> 4) * 256 + t + 4 * h * 16;
#pragma unroll
        for (int i = 0; i < 16; ++i) {
            const int s0 = (i & 3) + 8 * ((i >> 2) & 1);
            dst[(i >> 3) * 512 + s0 * 16] = (s0 + 4 * h < lim) ? acc[i] : 0.f;
        }
    }
    __builtin_amdgcn_s_waitcnt(0xc07f); asm volatile("" ::: "memory");
    f32x2_t kp[16];
#pragma unroll
    for (int t = 0; t < 16; ++t) kp[t].x = bf2f(LK[t * 72 + lane]);
#pragma unroll
    for (int q = 0; q < 4; ++q) {
        const f32x4 m = *(const f32x4*)(M4 + 512 + (lane & 15) * 16 + 4 * q);
        kp[4 * q].y = m.x; kp[4 * q + 1].y = m.y; kp[4 * q + 2].y = m.z; kp[4 * q + 3].y = m.w;
    }
    {
        f32x4 cf[2][4];
#pragma unroll
        for (int q = 0; q < 4; ++q) cf[0][q] = *(const f32x4*)(M4 + 4 * q);
#pragma unroll
        for (int s2 = 0; s2 < 15; ++s2) {
            if (s2 + 1 < 15) {
                int off = 0; asm volatile("" : "+v"(off) : "v"(kp[s2].x));
                const float* rowp = M4 + off + (s2 + 1) * 16;
#pragma unroll
                for (int q = (s2 + 2) >> 2; q < 4; ++q) cf[(s2 + 1) & 1][q] = *(const f32x4*)(rowp + 4 * q);
            }
            const f32x2_t sp = kp[s2];
#pragma unroll
            for (int t = s2 + 1; t < 16; ++t) {
                const float c = -cf[s2 & 1][t >> 2][t & 3];
                kp[t] = __builtin_elementwise_fma((f32x2_t){c, c}, sp, kp[t]);
            }
        }
    }
    const int pos = (lane & 0x30) | ((lane & 4) << 1) | ((lane & 8) >> 1) | (lane & 3);
    u16* A1p = A1 + 64 + (lane & 15);
    if (lane >= 16) A1p = A1 + 80 + (lane & 7);
#pragma unroll
    for (int t = 0; t < 16; ++t) {
        const unsigned pk = pack2(kp[t].x, kp[t].y);
        A1[C4_MU(t) * 88 + pos] = (u16)pk; A1p[C4_MU(t) * 88] = (u16)(pk >> 16);
    }
}
DI void c4_z(char* smem, int cz, int lane) {
    asm volatile("" : "+v"(lane));
    const u16* LR = (const u16*)(smem + C4_LR + (cz % 3) * C4_LKSZ);
    const float* M4 = (const float*)(smem + C4_M4 + (cz & 1) * C4_M4SZ);
    u16* A1 = (u16*)(smem + C4_A1 + (cz % 3) * C4_A1SZ);
    const int pos = (lane & 0x30) | ((lane & 4) << 1) | ((lane & 8) >> 1) | (lane & 3);
    f32x2_t kp[16], rq[16];
#pragma unroll
    for (int t = 0; t < 16; ++t) {
        kp[t].x = bf2f(A1[C4_MU(t) * 88 + pos]); kp[t].y = bf2f(A1[C4_MU(t) * 88 + 64 + (lane & 15)]);
        rq[t].x = bf2f(LR[t * 72 + lane]);
    }
#pragma unroll
    for (int q = 0; q < 4; ++q) {
        const f32x4 m = *(const f32x4*)(M4 + 768 + (lane & 15) * 16 + 4 * q);
        rq[4 * q].y = m.x; rq[4 * q + 1].y = m.y; rq[4 * q + 2].y = m.z; rq[4 * q + 3].y = m.w;
    }
    {
        f32x4 cf[2][4];
#pragma unroll
        for (int q = 0; q < 4; ++q) cf[0][q] = *(const f32x4*)(M4 + 256 + 4 * q);
#pragma unroll
        for (int s2 = 0; s2 < 16; ++s2) {
            if (s2 + 1 < 16) {
                int off = 0; asm volatile("" : "+v"(off) : "v"(rq[s2].x));
                const float* rowp = M4 + 256 + off + (s2 + 1) * 16;
#pragma unroll
                for (int q = (s2 + 1) >> 2; q < 4; ++q) cf[(s2 + 1) & 1][q] = *(const f32x4*)(rowp + 4 * q);
            }
#pragma unroll
            for (int t = s2; t < 16; ++t) {
                const float c = -cf[s2 & 1][t >> 2][t & 3];
                rq[t] = __builtin_elementwise_fma((f32x2_t){c, c}, kp[s2], rq[t]);
            }
        }
    }
    u16* A1p = A1 + 64 + (lane & 15);
    if (lane >= 16) A1p = A1 + 80 + (lane & 7);
#pragma unroll
    for (int t = 0; t < 16; ++t) {
        const unsigned pk = pack2(rq[t].x, rq[t].y);
        A1[(16 + C4_MU(t)) * 88 + pos] = (u16)pk; A1p[(16 + C4_MU(t)) * 88] = (u16)(pk >> 16);
    }
}
#define C4_PACKB(S, SP) __builtin_bit_cast(bf16x8, (u32x4){pack2(S[8 * (SP)], S[8 * (SP) + 1]), pack2(S[8 * (SP) + 2], S[8 * (SP) + 3]), \
                                                             pack2(S[8 * (SP) + 4], S[8 * (SP) + 5]), pack2(S[8 * (SP) + 6], S[8 * (SP) + 7])})
DI void ph3c_chain(const Params& p, char* smem, int chain) {
    const int tid = threadIdx.x, lane = tid & 63, wave = __builtin_amdgcn_readfirstlane(tid >> 6);
    const int dir = chain & 1, hd = (chain >> 1) & 7, b = chain >> 4;
    constexpr int NCH = SEQ / 16;
    __syncthreads();
    if (wave == 1) {
        C4Raw raw;
#pragma unroll
        for (int j = 0; j < 16; ++j) c4_load_step(raw, p, dir, c4_tokb0(b, hd, dir, 0) + (unsigned)j * (dir ? (unsigned)-1024 : 1024u), 2u * (unsigned)lane, j);
        raw.inv = c4_load_inv(p, b, hd, dir, 0, lane);
        const float kkc = p.k_k[hd * 64 + lane], kac = p.k_a[hd * 64 + lane];
        __builtin_amdgcn_s_waitcnt(0x0f70);
#pragma unroll 1
        for (int i = -3; i < NCH; ++i) {
            if (i + 3 < NCH) c4_x(raw, p, smem, i + 3, b, hd, dir, lane, kkc, kac);
            __syncthreads();
        }
    } else if (wave == 2) {
#pragma unroll 1
        for (int i = -3; i < NCH; ++i) {
            if (i + 2 >= 0 && i + 2 < NCH) c4_y(smem, i + 2, dir, lane);
            __syncthreads();
        }
    } else if (wave == 3) {
#pragma unroll 1
        for (int i = -3; i < NCH; ++i) {
            if (i + 1 >= 0 && i + 1 < NCH) c4_z(smem, i + 1, lane);
            __syncthreads();
        }
    } else {
        __syncthreads(); __syncthreads(); __syncthreads();
        f32x16 s00, s01, s10, s11;
#pragma unroll
        for (int i = 0; i < 16; ++i) { s00[i] = 0.f; s01[i] = 0.f; s10[i] = 0.f; s11[i] = 0.f; }
        u16* Y = (u16*)(p.ws + OFF_YF);
        const int r_ = lane & 31, h_ = lane >> 5;
#pragma unroll 1
        for (int c = 0; c < NCH; ++c) {
            int cc = c; asm volatile("" : "+s"(cc));
            int r = r_, h = h_; asm volatile("" : "+v"(r), "+v"(h));
            const u16* A1 = (const u16*)(smem + C4_A1 + (cc % 3) * C4_A1SZ);
            const char* setb = smem + C4_SETB + (cc & 3) * C4_SETBSZ;
            const u16* LBKT = (const u16*)setb; const u16* VT = (const u16*)(setb + C4_VT); const float* G16 = (const float*)(setb + C4_G16);
            const bf16x8 aq0 = *(const bf16x8*)(A1 + r * 88 + 8 * h), aq1 = *(const bf16x8*)(A1 + r * 88 + 16 + 8 * h);
            const bf16x8 aq2 = *(const bf16x8*)(A1 + r * 88 + 32 + 8 * h), aq3 = *(const bf16x8*)(A1 + r * 88 + 48 + 8 * h);
            const bf16x8 ap = *(const bf16x8*)(A1 + r * 88 + 64 + 8 * h);
            const bf16x8 vb0 = *(const bf16x8*)(VT + r * 24 + 8 * h), vb1 = *(const bf16x8*)(VT + (32 + r) * 24 + 8 * h);
            f32x16 xy0, xy1;
#pragma unroll
            for (int i = 0; i < 16; ++i) { xy0[i] = 0.f; xy1[i] = 0.f; }
            xy0 = MFMA32(aq0, C4_PACKB(s00, 0), xy0); xy1 = MFMA32(aq0, C4_PACKB(s01, 0), xy1);
            xy0 = MFMA32(aq1, C4_PACKB(s00, 1), xy0); xy1 = MFMA32(aq1, C4_PACKB(s01, 1), xy1);
            xy0 = MFMA32(aq2, C4_PACKB(s10, 0), xy0); xy1 = MFMA32(aq2, C4_PACKB(s11, 0), xy1);
            xy0 = MFMA32(aq3, C4_PACKB(s10, 1), xy0); xy1 = MFMA32(aq3, C4_PACKB(s11, 1), xy1);
            xy0 = MFMA32(ap, vb0, xy0); xy1 = MFMA32(ap, vb1, xy1);
            const bf16x8 ub0 = C4_PACKB(xy0, 0), ub1 = C4_PACKB(xy1, 0);
            {
                const bf16x8 l00 = *(const bf16x8*)(LBKT + r * 40 + 8 * h), l01 = *(const bf16x8*)(LBKT + r * 40 + 16 + 8 * h);
                const bf16x8 l10 = *(const bf16x8*)(LBKT + (32 + r) * 40 + 8 * h), l11 = *(const bf16x8*)(LBKT + (32 + r) * 40 + 16 + 8 * h);
                s00 = MFMA32(l00, ub0, s00); s01 = MFMA32(l00, ub1, s01); s10 = MFMA32(l10, ub0, s10); s11 = MFMA32(l10, ub1, s11);
                s00 = MFMA32(l01, vb0, s00); s01 = MFMA32(l01, vb1, s01); s10 = MFMA32(l11, vb0, s10); s11 = MFMA32(l11, vb1, s11);
            }
            {
                const unsigned vst = (unsigned)(dir * NTOK * 512 + hd * 64 + r);
#pragma unroll
                for (int j = 0; j < 8; ++j) {
                    const int stp = 16 * cc + 8 * h + j;
                    const unsigned tok = (unsigned)(b * SEQ + (dir ? (SEQ - 1 - stp) : stp));
                    Y[tok * 512u + vst] = f2bf(xy0[8 + j]);
                    Y[tok * 512u + vst + 32u] = f2bf(xy1[8 + j]);
                }
            }
#pragma unroll
            for (int g4 = 0; g4 < 4; ++g4) {
                const f32x4 ga = *(const f32x4*)(G16 + 8 * g4 + 4 * h), gb = *(const f32x4*)(G16 + 32 + 8 * g4 + 4 * h);
                s00[4 * g4 + 0] *= ga.x; s00[4 * g4 + 1] *= ga.y; s00[4 * g4 + 2] *= ga.z; s00[4 * g4 + 3] *= ga.w;
                s01[4 * g4 + 0] *= ga.x; s01[4 * g4 + 1] *= ga.y; s01[4 * g4 + 2] *= ga.z; s01[4 * g4 + 3] *= ga.w;
                s10[4 * g4 + 0] *= gb.x; s10[4 * g4 + 1] *= gb.y; s10[4 * g4 + 2] *= gb.z; s10[4 * g4 + 3] *= gb.w;
                s11[4 * g4 + 0] *= gb.x; s11[4 * g4 + 1] *= gb.y; s11[4 * g4 + 2] *= gb.z; s11[4 * g4 + 3] *= gb.w;
            }
            __syncthreads();
        }
    }
}

DI void ph4(const Params& p, int bid, int nb) {
    const u16* YF = (const u16*)(p.ws + OFF_YF); const u16* YB = (const u16*)(p.ws + OFF_YB);
    const u16* G = (const u16*)(p.ws + OFF_G); const u16* BON = (const u16*)(p.ws + OFF_BONUS);
    u16* RWOUT = (u16*)(p.ws + OFF_RWOUT);
#pragma unroll 2
    for (int e = bid * 256 + threadIdx.x; e < NTOK * 64; e += nb * 256) {
        const int tok = e >> 6, c = (e & 63) * 8;
        float yf[8], yb[8], g[8], bo[8], y[8];
        load8(YF + (size_t)tok * 512 + c, yf); load8(YB + (size_t)tok * 512 + c, yb);
        load8(G + (size_t)tok * 512 + c, g); load8(BON + (size_t)tok * 512 + c, bo);
        float s = 0.f;
#pragma unroll
        for (int j = 0; j < 8; ++j) { y[j] = yf[j] + yb[j]; s += y[j]; }
        const float mean = grp8_sum(s) * (1.f / 64.f);
        float vs = 0.f;
#pragma unroll
        for (int j = 0; j < 8; ++j) { const float d = y[j] - mean; vs += d * d; }
        const float var = grp8_sum(vs) * (1.f / 64.f);
        const float rn = rsqrtf(var + 64e-5f);
        const f32x4 ga = *(const f32x4*)(p.ln_g + c), gb = *(const f32x4*)(p.ln_g + c + 4);
        const f32x4 ba = *(const f32x4*)(p.ln_b + c), bb = *(const f32x4*)(p.ln_b + c + 4);
        const float lg[8] = {ga.x, ga.y, ga.z, ga.w, gb.x, gb.y, gb.z, gb.w};
        const float lb[8] = {ba.x, ba.y, ba.z, ba.w, bb.x, bb.y, bb.z, bb.w};
        float o[8];
#pragma unroll
        for (int j = 0; j < 8; ++j) o[j] = ((y[j] - mean) * rn * lg[j] + lb[j] + bo[j]) * g[j];
        store8(RWOUT + (size_t)tok * 512 + c, o);
    }
}


DI unsigned pk4_fp8(float a, float b, float c, float d) {
    int w = 0;
    w = __builtin_amdgcn_cvt_pk_fp8_f32(a, b, w, false);
    w = __builtin_amdgcn_cvt_pk_fp8_f32(c, d, w, true);
    return (unsigned)w;
}
DI void convert_fp8_rows(const float* __restrict__ src, unsigned char* __restrict__ dst, unsigned char* __restrict__ dst2, int split, float* __restrict__ scales, int bid, int nb) {
    const int lane = threadIdx.x & 63, wave = threadIdx.x >> 6;
    for (int row = bid * 4 + wave; row < 16384; row += nb * 4) {
        const f32x4* sp = (const f32x4*)(src + (size_t)row * 1024 + 16 * lane);
        const f32x4 v0 = sp[0], v1 = sp[1], v2 = sp[2], v3 = sp[3];
        float m = fmaxf(fmaxf(fabsf(v0.x), fabsf(v0.y)), fmaxf(fabsf(v0.z), fabsf(v0.w)));
        m = fmaxf(m, fmaxf(fmaxf(fabsf(v1.x), fabsf(v1.y)), fmaxf(fabsf(v1.z), fabsf(v1.w))));
        m = fmaxf(m, fmaxf(fmaxf(fabsf(v2.x), fabsf(v2.y)), fmaxf(fabsf(v2.z), fabsf(v2.w))));
        m = fmaxf(m, fmaxf(fmaxf(fabsf(v3.x), fabsf(v3.y)), fmaxf(fabsf(v3.z), fabsf(v3.w))));
        m = wave_max(m);
        const float scale = (m > 0.f) ? m * (1.f / 440.f) : 1.f;
        const float inv = 1.f / scale;
        u32x4 o;
        o.x = pk4_fp8(v0.x * inv, v0.y * inv, v0.z * inv, v0.w * inv);
        o.y = pk4_fp8(v1.x * inv, v1.y * inv, v1.z * inv, v1.w * inv);
        o.z = pk4_fp8(v2.x * inv, v2.y * inv, v2.z * inv, v2.w * inv);
        o.w = pk4_fp8(v3.x * inv, v3.y * inv, v3.z * inv, v3.w * inv);
        *(u32x4*)((row < split ? dst + (size_t)row * 1024 : dst2 + (size_t)(row - split) * 1024) + 16 * lane) = o;
        if (lane == 0) scales[row] = scale;
    }
}

DI void ph5(const Params& p, char* smem, int bid, int nb) {
    const int tid = threadIdx.x, lane = tid & 63, wave = tid >> 6;
    const int wr = wave >> 1, wc = wave & 1, r = lane & 31, h = lane >> 5;
    const u16* ATT = (const u16*)((char*)p.out + OUT_ATT);
    const u16* RWOUT = (const u16*)(p.ws + OFF_RWOUT);
    const u16* WT = (const u16*)(p.ws + OFF_WOUTT);
    const float* mod = (const float*)(p.ws + OFF_MOD);
    float* X1 = (float*)(p.ws + OFF_X1); float* ss2p = (float*)(p.ws + OFF_SS2P);
    u16* X1G = (u16*)(p.ws + OFF_X1G);
    int mt, nt;
    for (int rnd = 0; xcd_tile256(bid, nb, rnd, 8, mt, nt); ++rnd) {
      const int n0 = nt * 128;
      f32x16 accs[2][2][2];
#pragma unroll
      for (int hf = 0; hf < 2; ++hf) zero_acc(accs[hf]);
      gemm_bf16A_256(accs, ATT + (size_t)(mt * 256) * 512, 512, WT + (size_t)n0 * 1024, 1024, 8, smem);
      gemm_bf16A_256(accs, RWOUT + (size_t)(mt * 256) * 512, 512, WT + (size_t)n0 * 1024 + 512, 1024, 8, smem);
#pragma unroll
      for (int hf = 0; hf < 2; ++hf) {
        f32x16 (&acc)[2][2] = accs[hf];
        const int m0 = mt * 256 + hf * 128, b = m0 / SEQ;
        const float* gate = mod + b * 6144 + 2048 + n0;
        const float* sc2 = mod + b * 6144 + 4096 + n0;
        float* Fs = (float*)smem;
        __syncthreads();
#pragma unroll
        for (int mi = 0; mi < 2; ++mi)
#pragma unroll
            for (int ni = 0; ni < 2; ++ni)
#pragma unroll
                for (int i = 0; i < 16; ++i)
                    Fs[(wr * 64 + mi * 32 + (i & 3) + 8 * (i >> 2) + 4 * h) * 132 + wc * 64 + ni * 32 + r] = acc[mi][ni][i];
        __syncthreads();
#pragma unroll 4
        for (int j = 0; j < 16; ++j) {
            const int id = tid + 256 * j, row = id >> 5, c4 = id & 31;
            const f32x4 a = *(const f32x4*)(Fs + row * 132 + 4 * c4);
            const size_t go = (size_t)(m0 + row) * DM + n0 + 4 * c4;
            const f32x4 xv = *(const f32x4*)(p.x + go), gv = *(const f32x4*)(gate + 4 * c4);
            const f32x4 ng = *(const f32x4*)(p.norm2_g + n0 + 4 * c4), sv = *(const f32x4*)(sc2 + 4 * c4);
            f32x4 v;
            v.x = xv.x + gv.x * a.x; v.y = xv.y + gv.y * a.y; v.z = xv.z + gv.z * a.z; v.w = xv.w + gv.w * a.w;
            *(f32x4*)(X1 + go) = v;
            u32x2 o; o.x = pack2(v.x * ng.x * (1.f + sv.x), v.y * ng.y * (1.f + sv.y)); o.y = pack2(v.z * ng.z * (1.f + sv.z), v.w * ng.w * (1.f + sv.w));
            *(u32x2*)(X1G + go) = o;
            float ss = v.x * v.x + v.y * v.y + v.z * v.z + v.w * v.w;
            ss = row16_sum(ss);
            ss += dppm<0x142, 0xa>(ss);
            if ((lane & 31) == 31) ss2p[(size_t)(m0 + row) * 8 + nt] = ss;
        }
      }
    }
}

DI unsigned score_key(float s, int idx) {
    unsigned u = __float_as_uint(s);
    u = (u & 0x80000000u) ? ~u : (u | 0x80000000u);
    return (u & ~127u) | (unsigned)idx;
}
DI float key_score(unsigned k) {
    unsigned u = (k & ~127u) | 64u;
    u = (u & 0x80000000u) ? (u & 0x7fffffffu) : ~u;
    return __uint_as_float(u);
}
DI unsigned score_key8(float s, int tag) {
    unsigned u = __float_as_uint(s);
    u = (u & 0x80000000u) ? ~u : (u | 0x80000000u);
    return (u & ~255u) | (unsigned)tag;
}
DI float key_score8(unsigned k) {
    unsigned u = (k & ~255u) | 128u;
    u = (u & 0x80000000u) ? (u & 0x7fffffffu) : ~u;
    return __uint_as_float(u);
}
constexpr int LDS_S = 136;
constexpr int SMEM_RS_OFF = 79616 - 512;
template <int B> DI void sort16_desc(unsigned (&c)[64]) {
#pragma unroll
    for (int k = 2; k <= 16; k <<= 1)
#pragma unroll
        for (int j = k >> 1; j > 0; j >>= 1)
#pragma unroll
            for (int i = 0; i < 16; ++i) {
                const int l = i ^ j;
                if (l > i) {
                    const unsigned hi = max(c[B + i], c[B + l]), lo = min(c[B + i], c[B + l]);
                    const bool desc = (i & k) == 0;
                    c[B + i] = desc ? hi : lo; c[B + l] = desc ? lo : hi;
                }
            }
}
DI void bitonic_merge16_desc(unsigned (&t)[16]) {
#pragma unroll
    for (int j = 8; j > 0; j >>= 1)
#pragma unroll
        for (int i = 0; i < 16; ++i) {
            const int l = i ^ j;
            if (l > i) { const unsigned hi = max(t[i], t[l]), lo = min(t[i], t[l]); t[i] = hi; t[l] = lo; }
        }
}
DI void topk_tile(const f32x16 (&acc)[2][2], unsigned* S, unsigned* __restrict__ dst0, int wr, int wc, int r, int h) {
    const int tid = threadIdx.x;
#pragma unroll
    for (int mi = 0; mi < 2; ++mi)
#pragma unroll
        for (int ni = 0; ni < 2; ++ni)
#pragma unroll
            for (int i = 0; i < 16; ++i) {
                const int row = wr * 64 + mi * 32 + crow(i, h), col = wc * 64 + ni * 32 + r;
                S[row * LDS_S + (col >> 6) * 68 + (col & 63)] = score_key(acc[mi][ni][i], col);
            }
    __syncthreads();
    const int row = tid >> 1, half = tid & 1;
    const unsigned* base = S + row * LDS_S + half * 68;
    unsigned c[64];
#pragma unroll
    for (int j = 0; j < 16; ++j) {
        const u32x4 v = *(const u32x4*)(base + 4 * j);
        c[4 * j] = v.x; c[4 * j + 1] = v.y; c[4 * j + 2] = v.z; c[4 * j + 3] = v.w;
    }
    sort16_desc<0>(c); sort16_desc<16>(c); sort16_desc<32>(c); sort16_desc<48>(c);
    unsigned t[16], u[16];
#pragma unroll
    for (int i = 0; i < 16; ++i) { t[i] = max(c[i], c[31 - i]); u[i] = max(c[32 + i], c[63 - i]); }
    bitonic_merge16_desc(t); bitonic_merge16_desc(u);
#pragma unroll
    for (int i = 0; i < 16; ++i) t[i] = max(t[i], u[15 - i]);
    bitonic_merge16_desc(t);
#pragma unroll
    for (int i = 0; i < 16; ++i) u[i] = (unsigned)__builtin_amdgcn_update_dpp(0, (int)t[15 - i], 0xB1, 0xf, 0xf, false);
#pragma unroll
    for (int i = 0; i < 16; ++i) t[i] = max(t[i], u[i]);
    bitonic_merge16_desc(t);
    unsigned* dst = dst0 + (size_t)row * 256 + half * 8;
    *(u32x4*)dst = half ? (u32x4){t[8], t[9], t[10], t[11]} : (u32x4){t[0], t[1], t[2], t[3]};
    *(u32x4*)(dst + 4) = half ? (u32x4){t[12], t[13], t[14], t[15]} : (u32x4){t[4], t[5], t[6], t[7]};
}

DI void ph6(const Params& p, char* smem, int bid, int nb) {
    const int tid = threadIdx.x, lane = tid & 63, wave = tid >> 6;
    const int wr = wave >> 1, wc = wave & 1, r = lane & 31, h = lane >> 5;
    const float* ss2p = (const float*)(p.ws + OFF_SS2P);
    const float* SW = (const float*)(p.ws + OFF_SW);
    const u16* X1G = (const u16*)(p.ws + OFF_X1G);
    const u16* WT = (const u16*)(p.ws + OFF_WQT);
    const u16* KEYS = (const u16*)(p.ws + OFF_KEYS);
    unsigned* TOPK = (unsigned*)(p.ws + OFF_TOPK);
    int mt, nt;
    for (int rnd = 0; xcd_tile256(bid, nb, rnd, 16, mt, nt); ++rnd) {
        const int n0 = nt * 128;
        f32x16 accs[2][2][2];
#pragma unroll
        for (int hf = 0; hf < 2; ++hf) zero_acc(accs[hf]);
        gemm_bf16A_256(accs, X1G + (size_t)(mt * 256) * DM, DM, WT + (size_t)n0 * DM, DM, 16, smem);
#pragma unroll
        for (int hf = 0; hf < 2; ++hf) {
            f32x16 (&acc)[2][2] = accs[hf];
            const int m0 = mt * 256 + hf * 128, b = m0 / SEQ;
            const u16* kb = KEYS + (size_t)nt * 128 * 128 + (size_t)(wc * 64 + r) * 128 + 8 * h;
            bf16x8 kf0[8], kf1[8];
#pragma unroll
            for (int ks = 0; ks < 8; ++ks) { kf0[ks] = *(const bf16x8*)(kb + ks * 16); kf1[ks] = *(const bf16x8*)(kb + 32 * 128 + ks * 16); }
            const float sw0 = SW[b * 2048 + n0 + wc * 64 + r], sw1 = SW[b * 2048 + n0 + wc * 64 + 32 + r];
            float* rsS = (float*)(smem + SMEM_RS_OFF);
            if (tid < 128) rsS[tid] = rsqrtf(ss2_row(ss2p, m0 + tid) * (1.f / 1024.f) + 1e-6f);
            __syncthreads();
#pragma unroll
            for (int mi = 0; mi < 2; ++mi)
#pragma unroll
                for (int i = 0; i < 16; ++i) {
                    const float rs = rsS[wr * 64 + mi * 32 + crow(i, h)];
                    acc[mi][0][i] = acc[mi][0][i] * rs + sw0; acc[mi][1][i] = acc[mi][1][i] * rs + sw1;
                }
            u16* Os = (u16*)smem;
            __syncthreads();
            stage_tile_bf16<false>(Os, acc, wr, wc, r, h);
            __syncthreads();
            zero_acc(acc);
#pragma unroll
            for (int ks = 0; ks < 8; ++ks) {
                const bf16x8 b0 = kf0[ks], b1 = kf1[ks];
                const bf16x8 a0 = *(const bf16x8*)(Os + (wr * 64 + r) * LDO + ks * 16 + 8 * h);
                const bf16x8 a1 = *(const bf16x8*)(Os + (wr * 64 + 32 + r) * LDO + ks * 16 + 8 * h);
                acc[0][0] = MFMA32(a0, b0, acc[0][0]); acc[0][1] = MFMA32(a0, b1, acc[0][1]);
                acc[1][0] = MFMA32(a1, b0, acc[1][0]); acc[1][1] = MFMA32(a1, b1, acc[1][1]);
            }
            __syncthreads();
            topk_tile(acc, (unsigned*)smem, TOPK + ((size_t)m0 * 16 + nt) * 16, wr, wc, r, h);
            __syncthreads();
        }
    }
}

DI float gelu_as(float v) {
    const float av = fabsf(v), d = av * 0.2316418882f + 1.0f;
    const float t = __builtin_amdgcn_rcpf(d);
    float q = t * 0.5307027145f + (-0.7265760135f); q = q * t + 0.7107068705f; q = q * t + (-0.142248368f); q = q * t + 0.127414796f; q = q * t;
    const float e = __builtin_amdgcn_exp2f((v * v) * (-0.72134752044f));
    const float m = v * (q * e), r = v - m;
    return v < 0.f ? m : r;
}
DI float dot16_fp8(const u32x4 u, const float (&h)[16]) {
    float d0 = 0.f, d1 = 0.f;
#pragma unroll
    for (int w = 0; w < 4; ++w) {
        const f32x2_t lo = __builtin_amdgcn_cvt_pk_f32_fp8((int)u[w], false), hi = __builtin_amdgcn_cvt_pk_f32_fp8((int)u[w], true);
        d0 = fma_(lo.x, h[4 * w + 0], d0); d1 = fma_(lo.y, h[4 * w + 1], d1);
        d0 = fma_(hi.x, h[4 * w + 2], d0); d1 = fma_(hi.y, h[4 * w + 3], d1);
    }
    return d0 + d1;
}
DI void axpy16_fp8(float (&acc)[16], const float wgt, const u32x4 v) {
#pragma unroll
    for (int w = 0; w < 4; ++w) {
        const f32x2_t lo = __builtin_amdgcn_cvt_pk_f32_fp8((int)v[w], false), hi = __builtin_amdgcn_cvt_pk_f32_fp8((int)v[w], true);
        acc[4 * w + 0] = fma_(wgt, lo.x, acc[4 * w + 0]); acc[4 * w + 1] = fma_(wgt, lo.y, acc[4 * w + 1]);
        acc[4 * w + 2] = fma_(wgt, hi.x, acc[4 * w + 2]); acc[4 * w + 3] = fma_(wgt, hi.y, acc[4 * w + 3]);
    }
}
DI float wave_total(float x) {
    x = row16_sum(x);
    x += dppm<0x142, 0xa>(x);
    x += dppm<0x143, 0xc>(x);
    return __builtin_bit_cast(float, __builtin_amdgcn_readlane(__builtin_bit_cast(int, x), 63));
}
struct Rows8 { u32x4 r[8]; };
DI void g8_load(Rows8& rw, const unsigned* skey, int g, const unsigned char* T8, const unsigned char* T8hi, int split, int lane) {
#pragma unroll
    for (int q = 0; q < 8; ++q) {
        const int e = (int)__builtin_amdgcn_readfirstlane(skey[(q >> 2) * 128 + 4 * g + (q & 3)]);
        rw.r[q] = *(const u32x4*)((e < split ? T8 : T8hi) + (size_t)e * 1024 + 16 * lane);
    }
}
DI float g8_reduce(const float (&d)[8], int lane) {
    const bool b0 = lane & 1, b1 = lane & 2, b2 = lane & 4;
    float r4[4], s2[2];
#pragma unroll
    for (int j = 0; j < 4; ++j) { const float keep = b0 ? d[j + 4] : d[j], send = b0 ? d[j] : d[j + 4]; r4[j] = keep + dppmov<0xB1>(send); }
#pragma unroll
    for (int j = 0; j < 2; ++j) { const float keep = b1 ? r4[j + 2] : r4[j], send = b1 ? r4[j] : r4[j + 2]; s2[j] = keep + dppmov<0x4E>(send); }
    const float keep = b2 ? s2[1] : s2[0], send = b2 ? s2[0] : s2[1];
    float t = keep + __builtin_bit_cast(float, __builtin_amdgcn_ds_swizzle(__builtin_bit_cast(int, send), 0x101F));
    t += dppmov<0x128>(t);
    t += __builtin_bit_cast(float, __builtin_amdgcn_ds_swizzle(__builtin_bit_cast(int, t), 0x401F));
    t += __shfl_xor(t, 32);
    return t;
}
DI float g8_dot(const u32x4 u, const f32x2_t (&h2)[8]) {
    f32x2_t a0 = {0.f, 0.f}, a1 = {0.f, 0.f};
#pragma unroll
    for (int w = 0; w < 4; ++w) {
        const f32x2_t lo = __builtin_amdgcn_cvt_pk_f32_fp8((int)u[w], false), hi = __builtin_amdgcn_cvt_pk_f32_fp8((int)u[w], true);
        a0 = __builtin_elementwise_fma(lo, h2[2 * w], a0); a1 = __builtin_elementwise_fma(hi, h2[2 * w + 1], a1);
    }
    a0 += a1;
    return a0.x + a0.y;
}
DI void g8_axpy(f32x2_t (&acc)[8], const float wgt, const u32x4 v) {
    const f32x2_t w2 = {wgt, wgt};
#pragma unroll
    for (int w = 0; w < 4; ++w) {
        const f32x2_t lo = __builtin_amdgcn_cvt_pk_f32_fp8((int)v[w], false), hi = __builtin_amdgcn_cvt_pk_f32_fp8((int)v[w], true);
        acc[2 * w] = __builtin_elementwise_fma(w2, lo, acc[2 * w]); acc[2 * w + 1] = __builtin_elementwise_fma(w2, hi, acc[2 * w + 1]);
    }
}
constexpr int TPW = 2;
DI void ph7(const Params& p, char* smem, int bid, int nb) {
    const int tid = threadIdx.x, lane = tid & 63, wave = tid >> 6;
    unsigned* ekey8 = (unsigned*)(smem + wave * 10752);
    float* egate8 = (float*)(ekey8 + 1024);
    unsigned* skey = (unsigned*)(egate8 + 1024); float* sgate = (float*)(skey + 256);
    unsigned* cnt = (unsigned*)(sgate + 256);
    const unsigned* TOPK = (const unsigned*)(p.ws + OFF_TOPK);
    const float* X1 = (const float*)(p.ws + OFF_X1);
    const float* ss2p = (const float*)(p.ws + OFF_SS2P);
    const float* mod = (const float*)(p.ws + OFF_MOD);
    const unsigned char* U8 = p.ws + OFF_U8; const unsigned char* V8A = p.ws + OFF_V8A; const unsigned char* V8B = p.ws + OFF_V8B - (size_t)V8_SPLIT * 1024;
    const float* usc = (const float*)(p.ws + OFF_USC); const float* vsc = (const float*)(p.ws + OFF_VSC);
    const int nwaves = nb * 4, gw = bid * 4 + wave;
    for (int tokc = gw * TPW; tokc < NTOK; tokc += 4 * nwaves * TPW) {
      {
          const int slot = lane >> 3, hd = lane & 7;
          const int tok = tokc + (slot >> 1) * nwaves * TPW + (slot & 1);
          if (tok < NTOK) {
              const unsigned* l1 = TOPK + (size_t)tok * 256 + hd * 32; const unsigned* l2 = l1 + 16;
              float s1[16], s2[16];
#pragma unroll
              for (int q = 0; q < 4; ++q) {
                  const u32x4 a = *(const u32x4*)(l1 + 4 * q), bb = *(const u32x4*)(l2 + 4 * q);
                  s1[4 * q] = key_score(a.x); s1[4 * q + 1] = key_score(a.y); s1[4 * q + 2] = key_score(a.z); s1[4 * q + 3] = key_score(a.w);
                  s2[4 * q] = key_score(bb.x); s2[4 * q + 1] = key_score(bb.y); s2[4 * q + 2] = key_score(bb.z); s2[4 * q + 3] = key_score(bb.w);
              }
              unsigned c[64];
#pragma unroll
              for (int n = 0; n < 64; ++n) c[n] = 0u;
              {
                  int n = 0;
#pragma unroll
                  for (int i = 0; i < 16; ++i)
#pragma unroll
                      for (int j = 0; j < 16; ++j)
                          if ((i + 1) * (j + 1) <= 16) { c[n] = score_key8(s1[i] + s2[j], i * 16 + j); ++n; }
              }
              sort16_desc<0>(c); sort16_desc<16>(c); sort16_desc<32>(c); sort16_desc<48>(c);
              unsigned t[16], u[16];
#pragma unroll
              for (int i = 0; i < 16; ++i) { t[i] = max(c[i], c[31 - i]); u[i] = max(c[32 + i], c[63 - i]); }
              bitonic_merge16_desc(t); bitonic_merge16_desc(u);
#pragma unroll
              for (int i = 0; i < 16; ++i) t[i] = max(t[i], u[15 - i]);
              bitonic_merge16_desc(t);
              const float mx = key_score8(t[0]);
              float ex[16], den = 0.f;
#pragma unroll
              for (int k = 0; k < 16; ++k) { ex[k] = __expf(key_score8(t[k]) - mx); den += ex[k]; }
              const float iden = 1.f / den;
#pragma unroll
              for (int k = 0; k < 16; ++k) {
                  const unsigned e1 = l1[(t[k] >> 4) & 15u] & 127u, e2 = l2[t[k] & 15u] & 127u;
                  ekey8[slot * 128 + hd * 16 + k] = e1 * 128u + e2;
                  egate8[slot * 128 + hd * 16 + k] = ex[k] * iden;
              }
          }
      }
#pragma unroll 1
      for (int rnd = 0; rnd < 4; ++rnd) {
        const int tok0 = tokc + rnd * nwaves * TPW;
        if (tok0 >= NTOK) break;
        const unsigned* ekey = ekey8 + rnd * 256; const float* egate = egate8 + rnd * 256;
        cnt[lane] = 0u; cnt[64 + lane] = 0u;
        unsigned mykey[4]; float mygate[4];
#pragma unroll
        for (int j = 0; j < 4; ++j) { mykey[j] = ekey[lane + 64 * j]; mygate[j] = egate[lane + 64 * j]; }
        const unsigned bflip = (rnd & 1) ? 63u : 0u;
#pragma unroll
        for (int j = 0; j < 4; ++j) atomicAdd(&cnt[(j >> 1) * 64 + ((mykey[j] >> 8) ^ bflip)], 1u);
#pragma unroll
        for (int ts = 0; ts < 2; ++ts) {
            const unsigned c = cnt[ts * 64 + lane];
            unsigned incl = c;
#pragma unroll
            for (int d = 1; d < 64; d <<= 1) { const unsigned t = __shfl_up(incl, d); if (lane >= d) incl += t; }
            cnt[ts * 64 + lane] = incl - c;
        }
#pragma unroll
        for (int j = 0; j < 4; ++j) {
            const unsigned pos = atomicAdd(&cnt[(j >> 1) * 64 + ((mykey[j] >> 8) ^ bflip)], 1u);
            skey[(j >> 1) * 128 + pos] = mykey[j]; sgate[(j >> 1) * 128 + pos] = mygate[j];
        }
        f32x2_t hv[TPW][8];
#pragma unroll
        for (int ts = 0; ts < TPW; ++ts) {
            const int tok = tok0 + ts, b = tok / SEQ;
            const float rs = rsqrtf(ss2_row(ss2p, tok) * (1.f / 1024.f) + 1e-6f);
            const u16* xg = (const u16*)(p.ws + OFF_X1G) + (size_t)tok * DM + 16 * lane;
            const float* gsh = mod + b * 6144 + 3072 + 16 * lane;
            float xf[16];
            load8(xg, *(float(*)[8])&xf[0]); load8(xg + 8, *(float(*)[8])&xf[8]);
#pragma unroll
            for (int q = 0; q < 4; ++q) {
                const f32x4 hh = *(const f32x4*)(gsh + 4 * q);
                hv[ts][2 * q].x = xf[4 * q] * rs + hh.x;
                hv[ts][2 * q].y = xf[4 * q + 1] * rs + hh.y;
                hv[ts][2 * q + 1].x = xf[4 * q + 2] * rs + hh.z;
                hv[ts][2 * q + 1].y = xf[4 * q + 3] * rs + hh.w;
            }
        }
        f32x2_t oacc[TPW][8];
#pragma unroll
        for (int ts = 0; ts < TPW; ++ts)
#pragma unroll
            for (int j = 0; j < 8; ++j) oacc[ts][j] = (f32x2_t){0.f, 0.f};
        const int myq = 4 * (lane & 1) + (lane & 2) + ((lane >> 2) & 1);
        const int mypos = (myq >> 2) * 128 + (myq & 3);
        Rows8 ur, vr;
        g8_load(ur, skey, 0, U8, U8, 16384, lane);
#pragma unroll 1
        for (int g = 0; g < 32; ++g) {
            g8_load(vr, skey, g, V8A, V8B, V8_SPLIT, lane);
            const int mye = (int)skey[mypos + 4 * g];
            const float myus = usc[mye], myvs = vsc[mye], mygt = sgate[mypos + 4 * g];
            float d[8];
#pragma unroll
            for (int q = 0; q < 8; ++q) d[q] = g8_dot(ur.r[q], hv[q >> 2]);
            if (g + 1 < 32) g8_load(ur, skey, g + 1, U8, U8, 16384, lane);
            const float tot = g8_reduce(d, lane);
            const int wbits = __builtin_bit_cast(int, mygt * gelu_as(tot * myus) * myvs);
#pragma unroll
            for (int q = 0; q < 8; ++q) {
                const float w = __builtin_bit_cast(float, __builtin_amdgcn_readlane(wbits, ((q >> 2) & 1) + 2 * ((q >> 1) & 1) + 4 * (q & 1)));
                g8_axpy(oacc[q >> 2], w, vr.r[q]);
            }
        }
#pragma unroll
        for (int ts = 0; ts < TPW; ++ts) {
            const int tok = tok0 + ts, b = tok / SEQ;
            const float* xr = X1 + (size_t)tok * DM + 16 * lane; const float* g2v = mod + b * 6144 + 5120 + 16 * lane;
            float* orow = p.out + (size_t)tok * DM + 16 * lane;
#pragma unroll
            for (int q = 0; q < 4; ++q) {
                const f32x4 xv = *(const f32x4*)(xr + 4 * q), gv = *(const f32x4*)(g2v + 4 * q);
                f32x4 o;
                o.x = xv.x + gv.x * oacc[ts][2 * q].x; o.y = xv.y + gv.y * oacc[ts][2 * q].y;
                o.z = xv.z + gv.z * oacc[ts][2 * q + 1].x; o.w = xv.w + gv.w * oacc[ts][2 * q + 1].y;
                *(f32x4*)(orow + 4 * q) = o;
            }
        }
      }
    }
}

#if defined(__HIP_DEVICE_COMPILE__)
typedef const Params __attribute__((address_space(4)))* KargPtr;
DI Params kargs() { KargPtr k = (KargPtr)__builtin_amdgcn_kernarg_segment_ptr(); asm volatile("" : "+s"(k)); return *k; }
#define PK kargs()
#else
#define PK p
#endif
constexpr int SMEM_BYTES = 79616;
__global__ void __launch_bounds__(256, 2) fwd_megakernel(Params p) {
    cg::grid_group grid = cg::this_grid();
    __shared__ __attribute__((aligned(16))) char smem[SMEM_BYTES];
    __shared__ __attribute__((aligned(16))) unsigned xb_words[4];
    if (threadIdx.x == 0) { xb_words[0] = 0u; xb_words[1] = 0u; xb_words[2] = 0u; xb_words[3] = 0u; }
    __syncthreads();
    XcdBarrier bar = xcd_barrier_post((unsigned*)(p.ws + OFF_BAR), (volatile LAS unsigned*)xb_words);
    const int bid = blockIdx.x, nb = gridDim.x;

    ph0(PK, smem, bid, nb);
    xcd_barrier(bar);
    ph1a(PK, bid, nb);
    xcd_barrier(bar);
    ph1(PK, smem, bid, nb);
    xcd_barrier(bar);
    ph2a(PK, bid, nb);
    ph2b(PK, smem, bid, nb);
    xcd_barrier(bar);
    for (int chain = bid; chain < 128; chain += nb) ph3c_chain(PK, smem, chain);
    {
        int abid = bid, anb = nb;
        if (nb > 128) {
            abid = bid - 128; anb = nb - 128;
            if (nb == 512 && abid >= 128) abid = (abid < 256) ? abid + 128 : abid - 128;
        } else xcd_barrier(bar);
        if (abid >= 0) {
            const int rem = (NB * 4 * 32) % anb, cb = rem ? abid - rem : abid, cn = rem ? anb - rem : anb;
            ph2c(PK, smem, abid, anb);
            if (cb >= 0) {
                { const Params pl = PK; convert_fp8_rows(pl.U, pl.ws + OFF_U8, pl.ws + OFF_U8, 16384, (float*)(pl.ws + OFF_USC), cb, cn); }
                { const Params pl = PK; convert_fp8_rows(pl.V, pl.ws + OFF_V8A, pl.ws + OFF_V8B, V8_SPLIT, (float*)(pl.ws + OFF_VSC), cb, cn); }
            }
        }
    }
    xcd_barrier(bar);
    ph4(PK, bid, nb);
    xcd_barrier(bar);
    ph5(PK, smem, bid, nb);
    xcd_barrier(bar);
    ph6(PK, smem, bid, nb);
    xcd_barrier(bar);
    ph7(PK, smem, bid, nb);
}

extern "C" void kernel_launch(void* const* d_in, const int* in_sizes, int n_in,
                              void* d_out, int out_size, void* d_ws, size_t ws_size,
                              hipStream_t stream) {
    static int grid_blocks = 0;
    if (!grid_blocks) {
        int dev = 0, cus = 0, per_cu = 0;
        (void)hipGetDevice(&dev);
        (void)hipDeviceGetAttribute(&cus, hipDeviceAttributeMultiprocessorCount, dev);
        (void)hipOccupancyMaxActiveBlocksPerMultiprocessor(&per_cu, fwd_megakernel, 256, 0);
        if (per_cu > 2) per_cu = 2;
        if (per_cu < 1) per_cu = 1;
        grid_blocks = cus * per_cu;
    }
    (void)hipMemsetAsync(d_ws, 0, 65536, stream);
    Params p{};
    const float** pp = (const float**)&p;
    for (int i = 0; i < 27; ++i) pp[i] = (const float*)d_in[i];
    p.out = (float*)d_out; p.ws = (unsigned char*)d_ws;
    void* args[] = {&p};
    hipError_t e = hipLaunchCooperativeKernel((void*)fwd_megakernel, dim3(grid_blocks), dim3(256), args, 0, stream);
    if (e != hipSuccess) fprintf(stderr, "cooperative launch failed: %s (grid %d)\n", hipGetErrorString(e), grid_blocks);
}
```

```cpp
#include <hip/hip_runtime.h>
#include <hip/hip_cooperative_groups.h>
#include <stdint.h>
#include <cstdio>
namespace cg = cooperative_groups;

#define DI __device__ __forceinline__
typedef unsigned short u16;
using bf16x8 = __attribute__((ext_vector_type(8))) short;
using f32x16 = __attribute__((ext_vector_type(16))) float;
typedef __bf16 bf16x2_t __attribute__((ext_vector_type(2)));
typedef float f32x2_t __attribute__((ext_vector_type(2)));
typedef unsigned u32x4 __attribute__((ext_vector_type(4)));
typedef unsigned u32x2 __attribute__((ext_vector_type(2)));
typedef float f32x4 __attribute__((ext_vector_type(4)));
#define MFMA32(a, b, c) __builtin_amdgcn_mfma_f32_32x32x16_bf16((a), (b), (c), 0, 0, 0)

constexpr int NTOK = 16384, SEQ = 2048, DM = 1024, NB = 8;
constexpr int INC = 3456, RWC = 1920;
constexpr float LOG2E = 1.4426950408889634f;

constexpr size_t OFF_BAR   = 0;
constexpr size_t OFF_MOD   = 65536;
constexpr size_t OFF_RSTD1 = OFF_MOD + 8 * 6144 * 4;
constexpr size_t OFF_SS2   = OFF_RSTD1 + 65536;
constexpr size_t OFF_SW    = OFF_SS2 + 65536;
constexpr size_t OFF_W2T   = OFF_SW + 65536;
constexpr size_t OFF_A2T   = OFF_W2T + 131072;
constexpr size_t OFF_G2T   = OFF_A2T + 131072;
constexpr size_t OFF_KEYS  = OFF_G2T + 131072;
constexpr size_t OFF_WOUTT = OFF_KEYS + 524288;
constexpr size_t OFF_WQT   = OFF_WOUTT + 2097152;
constexpr size_t OFF_WINT  = OFF_WQT + 4194304;
constexpr size_t OFF_PRW   = OFF_WINT + 7077888;
constexpr size_t SZ_PRW    = (size_t)NTOK * RWC * 2;
constexpr size_t OFF_YF    = OFF_PRW;
constexpr size_t OFF_YB    = OFF_PRW + (size_t)NTOK * 512 * 2;
constexpr size_t OFF_U8    = OFF_PRW + (size_t)NTOK * 1024 * 2;
constexpr size_t OFF_V8A   = OFF_U8 + (size_t)16384 * 1024;
constexpr int    V8_SPLIT  = 12288;
static_assert(OFF_V8A + (size_t)V8_SPLIT * 1024 <= OFF_PRW + SZ_PRW, "fp8 tables overflow");
constexpr size_t OFF_GB    = OFF_PRW + SZ_PRW;
constexpr size_t OFF_G     = OFF_GB;
constexpr size_t OFF_BONUS = OFF_GB + (size_t)NTOK * 512 * 2;
constexpr size_t OFF_X1G   = OFF_GB;
constexpr size_t OFF_R     = OFF_GB + (size_t)NTOK * 1024 * 2;
constexpr size_t OFF_RS    = OFF_R;
constexpr size_t OFF_KS    = OFF_RS + (size_t)NTOK * 512 * 2;
constexpr size_t OFF_VS    = OFF_KS + (size_t)NTOK * 512 * 2;
constexpr size_t OFF_INVN  = OFF_VS + (size_t)NTOK * 512 * 2;
constexpr size_t OFF_DEC   = OFF_INVN + (size_t)NTOK * 8 * 4;
constexpr size_t OFF_AA    = OFF_DEC + (size_t)2 * NTOK * 512 * 4;
constexpr size_t OFF_REND  = OFF_AA + (size_t)2 * NTOK * 512 * 2;
constexpr size_t OFF_V8B   = OFF_REND;
constexpr size_t OFF_USC   = OFF_V8B + (size_t)(16384 - V8_SPLIT) * 1024;
constexpr size_t OFF_VSC   = OFF_USC + 65536;
constexpr size_t OFF_SS2P  = OFF_VSC + 65536;
static_assert(OFF_SS2P + (size_t)NTOK * 8 * 4 <= 268435456ull, "workspace overflow");
constexpr size_t OFF_H1    = OFF_R;
constexpr size_t OFF_RWOUT = OFF_R;
constexpr size_t OFF_TOPK  = OFF_R;
constexpr size_t OFF_X1    = OFF_R + (size_t)NTOK * 512 * 2;
constexpr size_t OFF_Q2    = OFF_X1 + (size_t)NTOK * 1024 * 4;
constexpr size_t OFF_Q2END = OFF_Q2 + (size_t)NTOK * 2048 * 2;
static_assert(OFF_Q2END <= OFF_REND, "overlay overflow");
static_assert(OFF_REND <= 268435456ull, "workspace overflow");
constexpr size_t OUT_QK = 0;
constexpr size_t OUT_VT = (size_t)NTOK * 1024 * 2;
constexpr size_t OUT_ATT = 50331648;

#define XB_TMO      128
#define XB_XCNT(j)  (256  + 64 * (j))
#define XB_XSUB(j)  (1280 + 64 * (j))
#define XB_XGEN(j)  (2304 + 64 * (j))
#define XB_TOP      3328
#define XB_TOPGEN   3392
#define XCD_BAR_WORDS 3456
#define XB_SPIN_CAP (1u << 20)
#define LAS __attribute__((address_space(3)))

DI unsigned xb_ld(unsigned* p)              { return __hip_atomic_load(p, __ATOMIC_RELAXED, __HIP_MEMORY_SCOPE_AGENT); }
DI unsigned xb_add(unsigned* p, unsigned v) { return __hip_atomic_fetch_add(p, v, __ATOMIC_RELAXED, __HIP_MEMORY_SCOPE_AGENT); }
DI unsigned xb_xcc_id() { return (unsigned)__builtin_amdgcn_s_getreg((3 << 11) | 20) & 0xFu; }
#define XB_SPIN(cond, bar) do { unsigned _sp = 0; while (cond) { __builtin_amdgcn_s_sleep(1); \
    if ((++_sp & 255u) == 0u) { if (xb_ld(&(bar)[XB_TMO])) break; if (_sp > XB_SPIN_CAP) { atomicAdd(&(bar)[XB_TMO], 1u); break; } } } } while (0)

struct XcdBarrier { unsigned* bar; unsigned x; volatile LAS unsigned* st; };

DI XcdBarrier xcd_barrier_post(unsigned* bar, volatile LAS unsigned* st) {
    XcdBarrier b; b.bar = bar; b.x = xb_xcc_id(); b.st = st;
    if (threadIdx.x == 0) (void)xb_add(&bar[XB_XCNT(b.x)], 1u);
    return b;
}
DI void xcd_barrier_complete(unsigned* bar, unsigned x, unsigned& nloc, unsigned& nx) {
    const unsigned G = gridDim.x * gridDim.y * gridDim.z;
    unsigned sum, cnt, mine, sp = 0u;
    for (;;) {
        sum = 0u; cnt = 0u; mine = 0u;
#pragma unroll
        for (unsigned j = 0; j < 16; ++j) { const unsigned c = xb_ld(&bar[XB_XCNT(j)]); sum += c; cnt += (c > 0u) ? 1u : 0u; mine = (j == x) ? c : mine; }
        if (sum == G) break;
        __builtin_amdgcn_s_sleep(1);
        if ((++sp & 255u) == 0u) { if (xb_ld(&bar[XB_TMO])) break; if (sp > XB_SPIN_CAP) { atomicAdd(&bar[XB_TMO], 1u); break; } }
    }
    nloc = mine > 0u ? mine : 1u; nx = cnt > 0u ? cnt : 1u;
}
DI void xcd_barrier(const XcdBarrier& b) {
    asm volatile("s_waitcnt vmcnt(0)" ::: "memory");
    __syncthreads();
    if (threadIdx.x == 0) {
        unsigned* bar = b.bar;
        __builtin_amdgcn_s_waitcnt(0);
        unsigned nloc = b.st[0], nx = b.st[1];
        if (nloc == 0u) { xcd_barrier_complete(bar, b.x, nloc, nx); b.st[0] = nloc; b.st[1] = nx; }
        const unsigned old = xb_add(&bar[XB_XSUB(b.x)], 1u);
        const unsigned gen = old / nloc;
        if (old + 1u == (gen + 1u) * nloc) {
            __builtin_amdgcn_fence(__ATOMIC_RELEASE, "agent");
            asm volatile("s_waitcnt vmcnt(0)" ::: "memory");
            const unsigned og = xb_add(&bar[XB_TOP], 1u);
            const unsigned tg = og / nx;
            if (og + 1u == (tg + 1u) * nx) xb_add(&bar[XB_TOPGEN], 1u);
            else XB_SPIN(xb_ld(&bar[XB_TOPGEN]) == tg, bar);
            __builtin_amdgcn_fence(__ATOMIC_ACQUIRE, "agent");
            xb_add(&bar[XB_XGEN(b.x)], 1u);
            asm volatile("s_waitcnt vmcnt(0)" ::: "memory");
        } else {
            XB_SPIN(xb_ld(&bar[XB_XGEN(b.x)]) == gen, bar);
            __builtin_amdgcn_fence(__ATOMIC_ACQUIRE, "agent");
            asm volatile("s_waitcnt vmcnt(0)" ::: "memory");
        }
    }
    __syncthreads();
}

DI float ss2_row(const float* ss2p, int row) {
    const float4 a = *(const float4*)(ss2p + (size_t)row * 8), b = *(const float4*)(ss2p + (size_t)row * 8 + 4);
    return ((a.x + a.y) + (a.z + a.w)) + ((b.x + b.y) + (b.z + b.w));
}
DI unsigned pack2(float lo, float hi) {
    f32x2_t v = {lo, hi};
    bf16x2_t b = __builtin_convertvector(v, bf16x2_t);
    return __builtin_bit_cast(unsigned, b);
}
DI u16 f2bf(float x) { return (u16)(pack2(x, 0.f) & 0xffffu); }
DI float bf2f(u16 b) { return __uint_as_float((unsigned)b << 16); }
DI float bflo(unsigned u) { return __uint_as_float(u << 16); }
DI float bfhi(unsigned u) { return __uint_as_float(u & 0xffff0000u); }
DI int crow(int reg, int h) { return (reg & 3) + 8 * (reg >> 2) + 4 * h; }
template <int CTRL> DI float dppmov(float x) {
    return __builtin_bit_cast(float, __builtin_amdgcn_update_dpp(0, __builtin_bit_cast(int, x), CTRL, 0xf, 0xf, false));
}
template <int CTRL, int RM> DI float dppm(float x) {
    return __builtin_bit_cast(float, __builtin_amdgcn_update_dpp(0, __builtin_bit_cast(int, x), CTRL, RM, 0xf, false));
}
DI float row16_sum(float x) {
    x += dppmov<0xB1>(x);  x += dppmov<0x4E>(x);  x += dppmov<0x124>(x);  x += dppmov<0x128>(x);
    return x;
}
DI float grp8_sum(float x) { x += __shfl_xor(x, 1); x += __shfl_xor(x, 2); x += __shfl_xor(x, 4); return x; }
DI float half_sum(float x) { x = row16_sum(x); x += __shfl_xor(x, 16); return x; }
DI float wave_sum(float x) { x = half_sum(x); x += __shfl_xor(x, 32); return x; }
DI float wave_max(float x) {
    x = fmaxf(x, __shfl_xor(x, 1)); x = fmaxf(x, __shfl_xor(x, 2)); x = fmaxf(x, __shfl_xor(x, 4));
    x = fmaxf(x, __shfl_xor(x, 8)); x = fmaxf(x, __shfl_xor(x, 16)); x = fmaxf(x, __shfl_xor(x, 32)); return x;
}
DI float fma_(float a, float b, float c) { float d; asm("v_fma_f32 %0, %1, %2, %3" : "=v"(d) : "v"(a), "v"(b), "v"(c)); return d; }
DI float mul_(float a, float b) { float d; asm("v_mul_f32 %0, %1, %2" : "=v"(d) : "v"(a), "v"(b)); return d; }
DI float add_(float a, float b) { float d; asm("v_add_f32 %0, %1, %2" : "=v"(d) : "v"(a), "v"(b)); return d; }
DI float sigmoidf_(float x) { return __builtin_amdgcn_rcpf(1.f + __expf(-x)); }

DI void load8(const u16* ptr, float (&o)[8]) {
    const u32x4 u = *(const u32x4*)ptr;
    o[0] = bflo(u.x); o[1] = bfhi(u.x); o[2] = bflo(u.y); o[3] = bfhi(u.y); o[4] = bflo(u.z); o[5] = bfhi(u.z); o[6] = bflo(u.w); o[7] = bfhi(u.w);
}
DI void store8(u16* ptr, const float (&v)[8]) {
    u32x4 o; o.x = pack2(v[0], v[1]); o.y = pack2(v[2], v[3]); o.z = pack2(v[4], v[5]); o.w = pack2(v[6], v[7]);
    *(u32x4*)ptr = o;
}
struct Params {
    const float *x, *c, *ada_w, *ada_b, *norm1_g, *w_in, *qn_g, *kn_g, *da_lambda, *subln_g,
                *mu, *w0, *w2, *a0, *a2, *g2, *k_k, *k_a, *r_k, *ln_g, *ln_b, *w_out, *norm2_g,
                *wq, *keys, *U, *V;
    float* out; unsigned char* ws;
};

DI void transpose_tile(const float* __restrict__ src, u16* __restrict__ dst, int R, int C, float* tile, int it) {
    const int tid = threadIdx.x;
    const int tc_n = C / 64;
    {
        const int tr = it / tc_n, tc = it % tc_n;
        __syncthreads();
#pragma unroll
        for (int i = 0; i < 4; ++i) {
            const int r = (tid >> 4) + 16 * i, c4 = tid & 15;
            const f32x4 v = *(const f32x4*)(src + (size_t)(64 * tr + r) * C + 64 * tc + 4 * c4);
            tile[r * 65 + 4 * c4 + 0] = v.x; tile[r * 65 + 4 * c4 + 1] = v.y; tile[r * 65 + 4 * c4 + 2] = v.z; tile[r * 65 + 4 * c4 + 3] = v.w;
        }
        __syncthreads();
#pragma unroll
        for (int i = 0; i < 2; ++i) {
            const int c = (tid >> 3) + 32 * i, r8 = (tid & 7) * 8;
            u32x4 o;
            o.x = pack2(tile[(r8 + 0) * 65 + c], tile[(r8 + 1) * 65 + c]);
            o.y = pack2(tile[(r8 + 2) * 65 + c], tile[(r8 + 3) * 65 + c]);
            o.z = pack2(tile[(r8 + 4) * 65 + c], tile[(r8 + 5) * 65 + c]);
            o.w = pack2(tile[(r8 + 6) * 65 + c], tile[(r8 + 7) * 65 + c]);
            *(u32x4*)(dst + (size_t)(64 * tc + c) * R + 64 * tr + r8) = o;
        }
    }
}
DI void convert_bf16(const float* __restrict__ src, u16* __restrict__ dst, size_t n, int bid, int nb) {
    const size_t n8 = n / 8;
    for (size_t i = (size_t)bid * 256 + threadIdx.x; i < n8; i += (size_t)nb * 256) {
        const f32x4 a = *(const f32x4*)(src + i * 8), b = *(const f32x4*)(src + i * 8 + 4);
        u32x4 o; o.x = pack2(a.x, a.y); o.y = pack2(a.z, a.w); o.z = pack2(b.x, b.y); o.w = pack2(b.z, b.w);
        *(u32x4*)(dst + i * 8) = o;
    }
}

DI void ph0(const Params& p, char* smem, int bid, int nb) {
    const int tid = threadIdx.x, lane = tid & 63, wave = tid >> 6;
    {
        float* sc = (float*)smem;
        float* red = sc + 8 * 1024;
        float* mod = (float*)(p.ws + OFF_MOD);
        bool loaded = false;
        for (int it = bid; it < 96; it += nb) {
            if (!loaded) {
                for (int i = tid; i < 8 * 1024; i += 256) { const float v = p.c[i]; sc[i] = v * __builtin_amdgcn_rcpf(1.f + __expf(-v)); }
                loaded = true;
            }
            __syncthreads();
            const int c4 = tid & 15, kq = tid >> 4;
            f32x4 acc[8];
#pragma unroll
            for (int b = 0; b < 8; ++b) acc[b] = (f32x4){0.f, 0.f, 0.f, 0.f};
#pragma unroll 8
            for (int k = kq * 64; k < kq * 64 + 64; ++k) {
                const f32x4 w = *(const f32x4*)(p.ada_w + (size_t)k * 6144 + 64 * it + 4 * c4);
#pragma unroll
                for (int b = 0; b < 8; ++b) acc[b] += sc[b * 1024 + k] * w;
            }
#pragma unroll
            for (int b = 0; b < 8; ++b) *(f32x4*)(red + (kq * 8 + b) * 64 + 4 * c4) = acc[b];
            __syncthreads();
            for (int e = tid; e < 512; e += 256) {
                const int b = e >> 6, cc = e & 63;
                float v = 0.f;
#pragma unroll
                for (int q = 0; q < 16; ++q) v += red[(q * 8 + b) * 64 + cc];
                mod[b * 6144 + 64 * it + cc] = v + p.ada_b[64 * it + cc];
            }
        }
        __syncthreads();
    }
    if (nb >= 256) { if (bid < 96) return; bid -= 96; nb -= 96; }
    float* tile = (float*)smem;
    for (int it = bid; it < 1680; it += nb) {
        if (it < 864) transpose_tile(p.w_in, (u16*)(p.ws + OFF_WINT), 1024, INC, tile, it);
        else if (it < 1120) transpose_tile(p.w_out, (u16*)(p.ws + OFF_WOUTT), 1024, 1024, tile, it - 864);
        else if (it < 1632) transpose_tile(p.wq, (u16*)(p.ws + OFF_WQT), 1024, 2048, tile, it - 1120);
        else if (it < 1648) { const int d = (it - 1632) >> 3; transpose_tile(p.w2 + (size_t)d * 64 * 512, (u16*)(p.ws + OFF_W2T) + (size_t)d * 512 * 64, 64, 512, tile, (it - 1632) & 7); }
        else if (it < 1664) { const int d = (it - 1648) >> 3; transpose_tile(p.a2 + (size_t)d * 64 * 512, (u16*)(p.ws + OFF_A2T) + (size_t)d * 512 * 64, 64, 512, tile, (it - 1648) & 7); }
        else transpose_tile(p.g2, (u16*)(p.ws + OFF_G2T), 128, 512, tile, it - 1664);
    }
    __syncthreads();
    convert_bf16(p.keys, (u16*)(p.ws + OFF_KEYS), (size_t)16 * 128 * 128, bid, nb);
}

constexpr int LDT = 72;
constexpr int GEMM_SMEM = 2 * 128 * LDT * 2;

DI void gemm_compute_tile(f32x16 (&acc)[2][2], const u16* As, const u16* Bs, int wr, int wc, int r, int h) {
#pragma unroll
    for (int ks = 0; ks < 4; ++ks) {
        const bf16x8 a0 = *(const bf16x8*)(As + (wr * 64 + r) * LDT + ks * 16 + 8 * h);
        const bf16x8 a1 = *(const bf16x8*)(As + (wr * 64 + 32 + r) * LDT + ks * 16 + 8 * h);
        const bf16x8 b0 = *(const bf16x8*)(Bs + (wc * 64 + r) * LDT + ks * 16 + 8 * h);
        const bf16x8 b1 = *(const bf16x8*)(Bs + (wc * 64 + 32 + r) * LDT + ks * 16 + 8 * h);
        acc[0][0] = MFMA32(a0, b0, acc[0][0]);
        acc[0][1] = MFMA32(a0, b1, acc[0][1]);
        acc[1][0] = MFMA32(a1, b0, acc[1][0]);
        acc[1][1] = MFMA32(a1, b1, acc[1][1]);
    }
}

DI bool xcd_tile(int bid, int nb, int rnd, int NT, int& mt, int& nt) {
    if (nb & 7) { const int it = bid + rnd * nb; if (it >= 128 * NT) return false; mt = it / NT; nt = it - mt * NT; return true; }
    const int x = bid & 7, j = bid >> 3, per = nb >> 3;
    const int t = rnd * per + j;
    if (t >= 16 * NT) return false;
    const int half = (t >= 8 * NT) ? 1 : 0, u = t - half * 8 * NT;
    nt = u >> 3; mt = x * 16 + half * 8 + (u & 7);
    return true;
}
constexpr int GEMM_STAGE = 2 * 128 * LDT;
DI void gemm_bf16A(f32x16 (&acc)[2][2], const u16* __restrict__ A, int lda, const u16* __restrict__ Bt, int ldb, int nk, char* smem) {
    u16* S0 = (u16*)smem;
    const int tid = threadIdx.x, lane = tid & 63, wave = tid >> 6;
    const int wr = wave >> 1, wc = wave & 1, r = lane & 31, h = lane >> 5;
    const int kc = tid & 7, r0 = tid >> 3;
    u32x4 ar[4], br[4];
    const u16* ap = A + (size_t)r0 * lda + 8 * kc; const u16* bp = Bt + (size_t)r0 * ldb + 8 * kc;
#define GEMM_LOAD(KT) _Pragma("unroll") for (int i = 0; i < 4; ++i) { \
        ar[i] = *(const u32x4*)(ap + (size_t)(32 * i) * lda + 64 * (KT)); br[i] = *(const u32x4*)(bp + (size_t)(32 * i) * ldb + 64 * (KT)); }
#define GEMM_STORE(BUF) _Pragma("unroll") for (int i = 0; i < 4; ++i) { \
        *(u32x4*)(S0 + (BUF) * GEMM_STAGE + (r0 + 32 * i) * LDT + 8 * kc) = ar[i]; \
        *(u32x4*)(S0 + (BUF) * GEMM_STAGE + 128 * LDT + (r0 + 32 * i) * LDT + 8 * kc) = br[i]; }
    GEMM_LOAD(0)
    __syncthreads();
    GEMM_STORE(0)
    if (nk > 1) { GEMM_LOAD(1) }
#pragma unroll 1
    for (int kt = 0; kt < nk; ++kt) {
        __syncthreads();
        const int cur = kt & 1;
        if (kt + 1 < nk) { GEMM_STORE(cur ^ 1) }
        if (kt + 2 < nk) { GEMM_LOAD(kt + 2) }
        gemm_compute_tile(acc, S0 + cur * GEMM_STAGE, S0 + cur * GEMM_STAGE + 128 * LDT, wr, wc, r, h);
    }
}

constexpr int LDT2 = 136;
DI void gemm_bf16A_k128(f32x16 (&acc)[2][2], const u16* __restrict__ A, int lda, const u16* __restrict__ Bt, int ldb, int nk, char* smem) {
    u16* As = (u16*)smem; u16* Bs = As + 128 * LDT2;
    const int tid = threadIdx.x, lane = tid & 63, wave = tid >> 6;
    const int wr = wave >> 1, wc = wave & 1, r = lane & 31, h = lane >> 5;
    const int kc = tid & 15, r0 = tid >> 4;
    u32x4 ar[8], br[8];
    const u16* ap = A + (size_t)r0 * lda + 8 * kc; const u16* bp = Bt + (size_t)r0 * ldb + 8 * kc;
#pragma unroll
    for (int i = 0; i < 8; ++i) { ar[i] = *(const u32x4*)(ap + (size_t)(16 * i) * lda); br[i] = *(const u32x4*)(bp + (size_t)(16 * i) * ldb); }
#pragma unroll 1
    for (int kt = 0; kt < nk; ++kt) {
        __syncthreads();
#pragma unroll
        for (int i = 0; i < 8; ++i) {
            *(u32x4*)(As + (r0 + 16 * i) * LDT2 + 8 * kc) = ar[i];
            *(u32x4*)(Bs + (r0 + 16 * i) * LDT2 + 8 * kc) = br[i];
        }
        __syncthreads();
        if (kt + 1 < nk) {
#pragma unroll
            for (int i = 0; i < 8; ++i) {
                ar[i] = *(const u32x4*)(ap + (size_t)(16 * i) * lda + 128 * (kt + 1));
                br[i] = *(const u32x4*)(bp + (size_t)(16 * i) * ldb + 128 * (kt + 1));
            }
        }
#pragma unroll
        for (int ks = 0; ks < 8; ++ks) {
            const bf16x8 a0 = *(const bf16x8*)(As + (wr * 64 + r) * LDT2 + ks * 16 + 8 * h);
            const bf16x8 a1 = *(const bf16x8*)(As + (wr * 64 + 32 + r) * LDT2 + ks * 16 + 8 * h);
            const bf16x8 b0 = *(const bf16x8*)(Bs + (wc * 64 + r) * LDT2 + ks * 16 + 8 * h);
            const bf16x8 b1 = *(const bf16x8*)(Bs + (wc * 64 + 32 + r) * LDT2 + ks * 16 + 8 * h);
            acc[0][0] = MFMA32(a0, b0, acc[0][0]); acc[0][1] = MFMA32(a0, b1, acc[0][1]);
            acc[1][0] = MFMA32(a1, b0, acc[1][0]); acc[1][1] = MFMA32(a1, b1, acc[1][1]);
        }
    }
}
DI void gemm_bf16A_256(f32x16 (&acc)[2][2][2], const u16* __restrict__ A, int lda, const u16* __restrict__ Bt, int ldb, int nk, char* smem) {
    u16* As = (u16*)smem; u16* Bs = As + 256 * LDT;
    const int tid = threadIdx.x, lane = tid & 63, wave = tid >> 6;
    const int wr = wave >> 1, wc = wave & 1, r = lane & 31, h = lane >> 5;
    const int kc = tid & 7, r0 = tid >> 3;
    u32x4 ar[8], br[4];
    const u16* ap = A + (size_t)r0 * lda + 8 * kc; const u16* bp = Bt + (size_t)r0 * ldb + 8 * kc;
#pragma unroll
    for (int i = 0; i < 8; ++i) ar[i] = *(const u32x4*)(ap + (size_t)(32 * i) * lda);
#pragma unroll
    for (int i = 0; i < 4; ++i) br[i] = *(const u32x4*)(bp + (size_t)(32 * i) * ldb);
#pragma unroll 1
    for (int kt = 0; kt < nk; ++kt) {
        __syncthreads();
#pragma unroll
        for (int i = 0; i < 8; ++i) *(u32x4*)(As + (r0 + 32 * i) * LDT + 8 * kc) = ar[i];
#pragma unroll
        for (int i = 0; i < 4; ++i) *(u32x4*)(Bs + (r0 + 32 * i) * LDT + 8 * kc) = br[i];
        __syncthreads();
        if (kt + 1 < nk) {
#pragma unroll
            for (int i = 0; i < 8; ++i) ar[i] = *(const u32x4*)(ap + (size_t)(32 * i) * lda + 64 * (kt + 1));
#pragma unroll
            for (int i = 0; i < 4; ++i) br[i] = *(const u32x4*)(bp + (size_t)(32 * i) * ldb + 64 * (kt + 1));
        }
        __builtin_amdgcn_s_setprio(1);
#pragma unroll
        for (int ks = 0; ks < 4; ++ks) {
            const bf16x8 b0 = *(const bf16x8*)(Bs + (wc * 64 + r) * LDT + ks * 16 + 8 * h);
            const bf16x8 b1 = *(const bf16x8*)(Bs + (wc * 64 + 32 + r) * LDT + ks * 16 + 8 * h);
#pragma unroll
            for (int hf = 0; hf < 2; ++hf) {
                const bf16x8 a0 = *(const bf16x8*)(As + (hf * 128 + wr * 64 + r) * LDT + ks * 16 + 8 * h);
                const bf16x8 a1 = *(const bf16x8*)(As + (hf * 128 + wr * 64 + 32 + r) * LDT + ks * 16 + 8 * h);
                acc[hf][0][0] = MFMA32(a0, b0, acc[hf][0][0]); acc[hf][0][1] = MFMA32(a0, b1, acc[hf][0][1]);
                acc[hf][1][0] = MFMA32(a1, b0, acc[hf][1][0]); acc[hf][1][1] = MFMA32(a1, b1, acc[hf][1][1]);
            }
        }
        __builtin_amdgcn_s_setprio(0);
    }
}
DI bool xcd_tile256(int bid, int nb, int rnd, int NT, int& mt, int& nt) {
    if (nb & 7) { const int it = bid + rnd * nb; if (it >= 64 * NT) return false; mt = it / NT; nt = it - mt * NT; return true; }
    const int x = bid & 7, j = bid >> 3, per = nb >> 3;
    const int t = rnd * per + j;
    if (t >= 8 * NT) return false;
    nt = t >> 3; mt = x * 8 + (t & 7);
    return true;
}
DI void gemm_f32A(f32x16 (&acc)[2][2], const float* __restrict__ X, const float (&rs)[8], const float* __restrict__ g,
                  const float* __restrict__ scale, const float* __restrict__ shift, const u16* __restrict__ Bt, char* smem) {
    u16* As = (u16*)smem; u16* Bs = As + 128 * LDT;
    const int tid = threadIdx.x, lane = tid & 63, wave = tid >> 6;
    const int wr = wave >> 1, wc = wave & 1, r = lane & 31, h = lane >> 5;
    const int kcA = tid & 15, rA = tid >> 4;
    const int kc = tid & 7, r0 = tid >> 3;
    f32x4 xr[8]; u32x4 br[4]; f32x4 gm, sh;
#pragma unroll
    for (int i = 0; i < 8; ++i) xr[i] = *(const f32x4*)(X + (size_t)(rA + 16 * i) * DM + 4 * kcA);
#pragma unroll
    for (int i = 0; i < 4; ++i) br[i] = *(const u32x4*)(Bt + (size_t)(r0 + 32 * i) * DM + 8 * kc);
    {
        const f32x4 gg = *(const f32x4*)(g + 4 * kcA), ss = *(const f32x4*)(scale + 4 * kcA);
        sh = *(const f32x4*)(shift + 4 * kcA);
        gm.x = gg.x * (1.f + ss.x); gm.y = gg.y * (1.f + ss.y); gm.z = gg.z * (1.f + ss.z); gm.w = gg.w * (1.f + ss.w);
    }
    for (int kt = 0; kt < 16; ++kt) {
        __syncthreads();
#pragma unroll
        for (int i = 0; i < 8; ++i) {
            const float s = rs[i];
            u32x2 o;
            o.x = pack2(xr[i].x * s * gm.x + sh.x, xr[i].y * s * gm.y + sh.y);
            o.y = pack2(xr[i].z * s * gm.z + sh.z, xr[i].w * s * gm.w + sh.w);
            *(u32x2*)(As + (rA + 16 * i) * LDT + 4 * kcA) = o;
        }
#pragma unroll
        for (int i = 0; i < 4; ++i) *(u32x4*)(Bs + (r0 + 32 * i) * LDT + 8 * kc) = br[i];
        __syncthreads();
        if (kt + 1 < 16) {
            const int k0 = 64 * (kt + 1);
#pragma unroll
            for (int i = 0; i < 8; ++i) xr[i] = *(const f32x4*)(X + (size_t)(rA + 16 * i) * DM + k0 + 4 * kcA);
#pragma unroll
            for (int i = 0; i < 4; ++i) br[i] = *(const u32x4*)(Bt + (size_t)(r0 + 32 * i) * DM + k0 + 8 * kc);
            const f32x4 gg = *(const f32x4*)(g + k0 + 4 * kcA), ss = *(const f32x4*)(scale + k0 + 4 * kcA);
            sh = *(const f32x4*)(shift + k0 + 4 * kcA);
            gm.x = gg.x * (1.f + ss.x); gm.y = gg.y * (1.f + ss.y); gm.z = gg.z * (1.f + ss.z); gm.w = gg.w * (1.f + ss.w);
        }
        gemm_compute_tile(acc, As, Bs, wr, wc, r, h);
    }
}
DI void zero_acc(f32x16 (&acc)[2][2]) {
#pragma unroll
    for (int a = 0; a < 2; ++a)
#pragma unroll
        for (int b = 0; b < 2; ++b)
#pragma unroll
            for (int i = 0; i < 16; ++i) acc[a][b][i] = 0.f;
}


constexpr int LDO = 136;
DI float half_total(float x, int h) {
    x = row16_sum(x);
    x += dppm<0x142, 0xa>(x);
    const float s0 = __builtin_bit_cast(float, __builtin_amdgcn_readlane(__builtin_bit_cast(int, x), 31));
    const float s1 = __builtin_bit_cast(float, __builtin_amdgcn_readlane(__builtin_bit_cast(int, x), 63));
    return h ? s1 : s0;
}
template <bool TRANSPOSE> DI void stage_tile_bf16(u16* Os, const f32x16 (&acc)[2][2], int wr, int wc, int r, int h) {
#pragma unroll
    for (int mi = 0; mi < 2; ++mi)
#pragma unroll
        for (int ni = 0; ni < 2; ++ni)
#pragma unroll
            for (int i = 0; i < 16; ++i) {
                const int row = wr * 64 + mi * 32 + (i & 3) + 8 * (i >> 2) + 4 * h, col = wc * 64 + ni * 32 + r;
                Os[TRANSPOSE ? (col * LDO + row) : (row * LDO + col)] = f2bf(acc[mi][ni][i]);
            }
}
DI void flush_tile_bf16(const u16* Os, u16* __restrict__ dst, int ld) {
    int tid = threadIdx.x;
    asm volatile("" : "+v"(tid));
#pragma unroll
    for (int j = 0; j < 8; ++j) {
        const int id = tid + 256 * j, row = id >> 4, c16 = id & 15;
        const u32x4 v = *(const u32x4*)(Os + row * LDO + c16 * 8);
        *(u32x4*)((char*)dst + (unsigned)((row * ld + c16 * 8) * 2)) = v;
    }
}

DI void ph1a(const Params& p, int bid, int nb) {
    const int tid = threadIdx.x, lane = tid & 63, wave = tid >> 6;
    const float* mod = (const float*)(p.ws + OFF_MOD);
    u16* H1 = (u16*)(p.ws + OFF_H1);
    f32x4 nx[4];
    {
        const int row0 = bid * 4 + wave;
        if (row0 < NTOK) {
            const f32x4* xr = (const f32x4*)(p.x + (size_t)row0 * DM + 16 * lane);
#pragma unroll
            for (int q = 0; q < 4; ++q) nx[q] = xr[q];
        }
    }
    for (int row = bid * 4 + wave; row < NTOK; row += nb * 4) {
        const int b = row / SEQ;
        const f32x4* gp = (const f32x4*)(p.norm1_g + 16 * lane);
        const f32x4* scp = (const f32x4*)(mod + b * 6144 + 1024 + 16 * lane);
        const f32x4* shp = (const f32x4*)(mod + b * 6144 + 16 * lane);
        f32x4 xv[4];
        float ss = 0.f;
#pragma unroll
        for (int q = 0; q < 4; ++q) { xv[q] = nx[q]; ss += xv[q].x * xv[q].x + xv[q].y * xv[q].y + xv[q].z * xv[q].z + xv[q].w * xv[q].w; }
        if (row + nb * 4 < NTOK) {
            const f32x4* xr = (const f32x4*)(p.x + (size_t)(row + nb * 4) * DM + 16 * lane);
#pragma unroll
            for (int q = 0; q < 4; ++q) nx[q] = xr[q];
        }
        ss = wave_sum(ss);
        const float rs = rsqrtf(ss * (1.f / 1024.f) + 1e-6f);
        unsigned o[8];
#pragma unroll
        for (int q = 0; q < 4; ++q) {
            const f32x4 g = gp[q], sc = scp[q], sh = shp[q];
            o[2 * q]     = pack2(xv[q].x * rs * g.x * (1.f + sc.x) + sh.x, xv[q].y * rs * g.y * (1.f + sc.y) + sh.y);
            o[2 * q + 1] = pack2(xv[q].z * rs * g.z * (1.f + sc.z) + sh.z, xv[q].w * rs * g.w * (1.f + sc.w) + sh.w);
        }
        u32x4* dst = (u32x4*)(H1 + (size_t)row * DM + 16 * lane);
        dst[0] = (u32x4){o[0], o[1], o[2], o[3]}; dst[1] = (u32x4){o[4], o[5], o[6], o[7]};
    }
    const u16* WQT = (const u16*)(p.ws + OFF_WQT);
    float* SW = (float*)(p.ws + OFF_SW);
    for (int n = bid * 4 + wave; n < 2048; n += nb * 4) {
        float w[16];
        load8(WQT + (size_t)n * DM + 16 * lane, *(float(*)[8])&w[0]);
        load8(WQT + (size_t)n * DM + 16 * lane + 8, *(float(*)[8])&w[8]);
#pragma unroll 1
        for (int b = 0; b < 8; ++b) {
            const f32x4* shp = (const f32x4*)(mod + b * 6144 + 3072 + 16 * lane);
            float sacc = 0.f;
#pragma unroll
            for (int q = 0; q < 4; ++q) { const f32x4 sh = shp[q]; sacc += sh.x * w[4 * q] + sh.y * w[4 * q + 1] + sh.z * w[4 * q + 2] + sh.w * w[4 * q + 3]; }
            sacc = wave_sum(sacc);
            if (lane == 0) SW[b * 2048 + n] = sacc;
        }
    }
}

DI void ph1_epilogue(const Params& p, char* smem, f32x16 (&acc)[2][2], int m0, int nt) {
    const int tid = threadIdx.x, lane = tid & 63, wave = tid >> 6;
    const int wr = wave >> 1, wc = wave & 1, r = lane & 31, h = lane >> 5;
    u16* QK = (u16*)((char*)p.out + OUT_QK); u16* VT = (u16*)((char*)p.out + OUT_VT);
    u16* PRW = (u16*)(p.ws + OFF_PRW);
    const int n0 = nt * 128, b = m0 / SEQ;
    u16* Os = (u16*)smem;
    if (nt < 8) {
        const float* gv = (nt < 4) ? p.qn_g : p.kn_g;
        const float mul = (nt < 4) ? 0.125f * LOG2E : 1.f;
        const float g0 = gv[r] * mul, g1 = gv[32 + r] * mul;
#pragma unroll
        for (int mi = 0; mi < 2; ++mi)
#pragma unroll
            for (int i = 0; i < 16; ++i) {
                const float v0 = acc[mi][0][i], v1 = acc[mi][1][i];
                const float ss = half_total(v0 * v0 + v1 * v1, h);
                const float rn = rsqrtf(ss * (1.f / 64.f) + 1e-6f);
                acc[mi][0][i] = v0 * rn * g0; acc[mi][1][i] = v1 * rn * g1;
            }
    }
    __syncthreads();
    if (nt >= 8 && nt < 12) stage_tile_bf16<true>(Os, acc, wr, wc, r, h);
    else stage_tile_bf16<false>(Os, acc, wr, wc, r, h);
    __syncthreads();
    if (nt < 8) flush_tile_bf16(Os, QK + (size_t)m0 * 1024 + n0, 1024);
    else if (nt < 12) flush_tile_bf16(Os, VT + ((size_t)(b * 4 + (nt - 8)) * 128) * SEQ + (m0 % SEQ), SEQ);
    else flush_tile_bf16(Os, PRW + (size_t)m0 * RWC + (n0 - 1536), RWC);
}
DI void ph1(const Params& p, char* smem, int bid, int nb) {
    const u16* H1 = (const u16*)(p.ws + OFF_H1);
    const u16* WT = (const u16*)(p.ws + OFF_WINT);
    const bool xcd = !(nb & 7);
    const int x = bid & 7, j = bid >> 3, per = nb >> 3;
    const int full = xcd ? 216 / per : 0;
    for (int rnd = 0; rnd < full; ++rnd) {
        const int t = rnd * per + j, nt = t >> 3, mt = x * 8 + (t & 7);
        f32x16 accs[2][2][2];
#pragma unroll
        for (int hf = 0; hf < 2; ++hf) zero_acc(accs[hf]);
        gemm_bf16A_256(accs, H1 + (size_t)(mt * 256) * DM, DM, WT + (size_t)(nt * 128) * DM, DM, 16, smem);
#pragma unroll
        for (int hf = 0; hf < 2; ++hf) ph1_epilogue(p, smem, accs[hf], mt * 256 + hf * 128, nt);
    }
    const int lim = xcd ? 2 * (216 - full * per) : 128 * 27;
    for (int u = xcd ? j : bid; u < lim; u += xcd ? per : nb) {
        int m0, nt;
        if (xcd) { const int t = full * per + (u >> 1); nt = t >> 3; m0 = (x * 8 + (t & 7)) * 256 + (u & 1) * 128; }
        else { const int mt = u / 27; nt = u - mt * 27; m0 = mt * 128; }
        f32x16 acc[2][2]; zero_acc(acc);
        gemm_bf16A_k128(acc, H1 + (size_t)m0 * DM, DM, WT + (size_t)(nt * 128) * DM, DM, 8, smem);
        ph1_epilogue(p, smem, acc, m0, nt);
    }
}

DI void shifted8(const u16* PRW, const float* mu, int tok, int c, float (&o)[8]) {
    const int t = tok % SEQ;
    float cur[8], prv[8], nxt[8];
    load8(PRW + (size_t)tok * RWC + c, cur);
    if (t > 0) load8(PRW + (size_t)(tok - 1) * RWC + c, prv); else {
#pragma unroll
        for (int j = 0; j < 8; ++j) prv[j] = 0.f; }
    if (t < SEQ - 1) load8(PRW + (size_t)(tok + 1) * RWC + c, nxt); else {
#pragma unroll
        for (int j = 0; j < 8; ++j) nxt[j] = 0.f; }
    const f32x4 m0a = *(const f32x4*)(mu + c), m0b = *(const f32x4*)(mu + c + 4);
    const f32x4 m1a = *(const f32x4*)(mu + RWC + c), m1b = *(const f32x4*)(mu + RWC + c + 4);
    const float m0[8] = {m0a.x, m0a.y, m0a.z, m0a.w, m0b.x, m0b.y, m0b.z, m0b.w};
    const float m1[8] = {m1a.x, m1a.y, m1a.z, m1a.w, m1b.x, m1b.y, m1b.z, m1b.w};
#pragma unroll
    for (int j = 0; j < 8; ++j) o[j] = cur[j] + m0[j] * (prv[j] - cur[j]) + m1[j] * (nxt[j] - cur[j]);
}
DI void shifted8c(const u16* PRW, const float (&m0)[8], const float (&m1)[8], int tok, int c, float (&o)[8]) {
    const int t = tok % SEQ;
    float cur[8], prv[8], nxt[8];
    load8(PRW + (size_t)tok * RWC + c, cur);
    if (t > 0) load8(PRW + (size_t)(tok - 1) * RWC + c, prv); else {
#pragma unroll
        for (int j = 0; j < 8; ++j) prv[j] = 0.f; }
    if (t < SEQ - 1) load8(PRW + (size_t)(tok + 1) * RWC + c, nxt); else {
#pragma unroll
        for (int j = 0; j < 8; ++j) nxt[j] = 0.f; }
#pragma unroll
    for (int j = 0; j < 8; ++j) o[j] = cur[j] + m0[j] * (prv[j] - cur[j]) + m1[j] * (nxt[j] - cur[j]);
}
DI void load8f(const float* ptr, float (&o)[8]) {
    const f32x4 a = *(const f32x4*)ptr, b = *(const f32x4*)(ptr + 4);
    o[0] = a.x; o[1] = a.y; o[2] = a.z; o[3] = a.w; o[4] = b.x; o[5] = b.y; o[6] = b.z; o[7] = b.w;
}
DI void ph2a(const Params& p, int bid, int nb) {
    const u16* PRW = (const u16*)(p.ws + OFF_PRW);
    u16* RS = (u16*)(p.ws + OFF_RS); u16* KS = (u16*)(p.ws + OFF_KS); u16* VS = (u16*)(p.ws + OFF_VS);
    float* RKR = (float*)(p.ws + OFF_BONUS); float* INVN = (float*)(p.ws + OFF_INVN);
    const int c = (threadIdx.x & 63) * 8, hd = c >> 6;
    float mr0[8], mr1[8], mk0[8], mk1[8], mv0[8], mv1[8], kkv[8], rkv[8];
    load8f(p.mu + c, mr0); load8f(p.mu + RWC + c, mr1);
    load8f(p.mu + 512 + c, mk0); load8f(p.mu + RWC + 512 + c, mk1);
    load8f(p.mu + 1024 + c, mv0); load8f(p.mu + RWC + 1024 + c, mv1);
    load8f(p.k_k + c, kkv); load8f(p.r_k + c, rkv);
    for (int e = bid * 256 + threadIdx.x; e < NTOK * 64; e += nb * 256) {
        const int tok = e >> 6;
        float rr[8], kk[8], vv[8];
        shifted8c(PRW, mr0, mr1, tok, c, rr);
        shifted8c(PRW, mk0, mk1, tok, 512 + c, kk);
        shifted8c(PRW, mv0, mv1, tok, 1024 + c, vv);
        float ssq = 0.f, rkr = 0.f;
#pragma unroll
        for (int j = 0; j < 8; ++j) { const float t = kk[j] * kkv[j]; ssq += t * t; rkr += rr[j] * kk[j] * rkv[j]; }
        ssq = grp8_sum(ssq); rkr = grp8_sum(rkr);
        store8(RS + (size_t)tok * 512 + c, rr); store8(KS + (size_t)tok * 512 + c, kk); store8(VS + (size_t)tok * 512 + c, vv);
        if ((e & 7) == 0) { RKR[tok * 8 + hd] = rkr; INVN[tok * 8 + hd] = 1.f / fmaxf(sqrtf(ssq), 1e-12f); }
    }
}

constexpr int LDP = 136;
DI void ph2b(const Params& p, char* smem, int bid, int nb) {
    const int tid = threadIdx.x, lane = tid & 63, wave = tid >> 6, r = lane & 31, h = lane >> 5;
    u16* TW = (u16*)smem; u16* AD = TW + 32 * LDP; u16* SG = AD + 32 * LDP;
    u16* OT = SG + 32 * LDP + wave * (32 * LDP);
    const u16* PRW = (const u16*)(p.ws + OFF_PRW);
    const u16* W2T = (const u16*)(p.ws + OFF_W2T); const u16* A2T = (const u16*)(p.ws + OFF_A2T); const u16* G2T = (const u16*)(p.ws + OFF_G2T);
    u16* DEC = (u16*)(p.ws + OFF_DEC); u16* AA = (u16*)(p.ws + OFF_AA); u16* G = (u16*)(p.ws + OFF_G);
    for (int it = bid; it < NTOK / 32; it += nb) {
        const int tok0 = it * 32;
        __syncthreads();
        for (int e = tid; e < 32 * 48; e += 256) {
            const int tl = e / 48, c8 = (e % 48) * 8;
            float v[8];
            shifted8(PRW, p.mu, tok0 + tl, 1536 + c8, v);
            if (c8 < 128) {
#pragma unroll
                for (int j = 0; j < 8; ++j) v[j] = 1.f - 2.f * __builtin_amdgcn_rcpf(1.f + __expf(2.f * v[j]));
                store8(TW + tl * LDP + c8, v);
            } else if (c8 < 256) {
                store8(AD + tl * LDP + (c8 - 128), v);
            } else {
#pragma unroll
                for (int j = 0; j < 8; ++j) v[j] = sigmoidf_(v[j]);
                store8(SG + tl * LDP + (c8 - 256), v);
            }
        }
        __syncthreads();
        bf16x8 bcur[8], bnxt[8];
#define P2_LOADB(DST, IT) { const int g_ = (IT) >> 2, n_ = wave * 128 + ((IT) & 3) * 32 + r, d_ = g_ & 1; \
            const u16* bs_ = (g_ < 2) ? W2T + (size_t)d_ * 512 * 64 : (g_ < 4 ? A2T + (size_t)d_ * 512 * 64 : G2T); \
            const int ldb_ = (g_ < 4) ? 64 : 128; \
            _Pragma("unroll") for (int ks = 0; ks < 4; ++ks) DST[ks] = *(const bf16x8*)(bs_ + (size_t)n_ * ldb_ + ks * 16 + 8 * h); \
            if (g_ == 4) { _Pragma("unroll") for (int ks = 4; ks < 8; ++ks) DST[ks] = *(const bf16x8*)(bs_ + (size_t)n_ * ldb_ + ks * 16 + 8 * h); } }
        P2_LOADB(bcur, 0)
#pragma unroll 1
        for (int it = 0; it < 20; ++it) {
            const int gsel = it >> 2, ni = it & 3, dir = gsel & 1;
            const u16* Asrc = (gsel < 2) ? TW : (gsel < 4 ? AD : SG);
            const int acol = (gsel < 4) ? dir * 64 : 0;
            const int n = wave * 128 + ni * 32 + r;
            if (it + 1 < 20) P2_LOADB(bnxt, it + 1)
            f32x16 acc0;
#pragma unroll
            for (int i = 0; i < 16; ++i) acc0[i] = 0.f;
#pragma unroll
            for (int ks = 0; ks < 4; ++ks) {
                const bf16x8 a0 = *(const bf16x8*)(Asrc + r * LDP + acol + ks * 16 + 8 * h);
                acc0 = MFMA32(a0, bcur[ks], acc0);
            }
            if (gsel == 4) {
#pragma unroll
                for (int ks = 4; ks < 8; ++ks) {
                    const bf16x8 a0 = *(const bf16x8*)(Asrc + r * LDP + acol + ks * 16 + 8 * h);
                    acc0 = MFMA32(a0, bcur[ks], acc0);
                }
            }
            if (gsel < 2) {
                const float w0v = p.w0[dir * 512 + n];
#pragma unroll
                for (int i = 0; i < 16; ++i) {
                    const float pre = w0v + acc0[i];
                    const float dec = __expf(-0.60653066f * sigmoidf_(pre));
                    OT[crow(i, h) * LDP + ni * 32 + r] = f2bf(1.f - dec);
                }
            } else if (gsel < 4) {
                const float a0v = p.a0[dir * 512 + n];
#pragma unroll
                for (int i = 0; i < 16; ++i) {
                    const float a = sigmoidf_(a0v + acc0[i]);
                    OT[crow(i, h) * LDP + ni * 32 + r] = f2bf(a);
                }
            } else {
#pragma unroll
                for (int i = 0; i < 16; ++i)
                    OT[crow(i, h) * LDP + ni * 32 + r] = f2bf(acc0[i]);
            }
            if (ni == 3) {
                u16* dst = (gsel < 2) ? DEC + (size_t)dir * NTOK * 512 : (gsel < 4 ? AA + (size_t)dir * NTOK * 512 : G);
                dst += (size_t)tok0 * 512 + wave * 128 + (lane & 15) * 8;
#pragma unroll
                for (int q = 0; q < 8; ++q) {
                    const int row = q * 4 + (lane >> 4);
                    *(u32x4*)(dst + (size_t)row * 512) = *(const u32x4*)(OT + row * LDP + (lane & 15) * 8);
                }
            }
#pragma unroll
            for (int ks = 0; ks < 8; ++ks) bcur[ks] = bnxt[ks];
        }
    }
}

constexpr int LDK = 136, LDV = 68, ATT_STAGE = 64 * LDK + 128 * LDV;
DI void ph2c(const Params& p, char* smem, int bid, int nb) {
    const int tid = threadIdx.x, lane = tid & 63, wave = tid >> 6, r = lane & 31, h = lane >> 5;
    const int qg = wave >> 1, c = wave & 1;
    u16* Kt = (u16*)smem; u16* Vs = Kt + 64 * LDK;
    float* exch = (float*)smem;
    u16* QK = (u16*)((char*)p.out + OUT_QK); const u16* VT = (const u16*)((char*)p.out + OUT_VT);
    float lam, M2;
    {
        const float l0 = p.da_lambda[lane], l1 = p.da_lambda[64 + lane], l2 = p.da_lambda[128 + lane], l3 = p.da_lambda[192 + lane];
        const float s1 = wave_sum(l0 * l1), s2 = wave_sum(l2 * l3);
        lam = __expf(s1) - __expf(s2) + 0.2f;
        const float mq = wave_max(fabsf(p.qn_g[lane])), mk = wave_max(fabsf(p.kn_g[lane]));
        M2 = 8.f * mq * mk * LOG2E;
    }
    bf16x8 qfr[4];
    const u16* kg; const u16* vg;
    u32x4 kreg[4], vreg[4];
    const unsigned koff = (unsigned)((tid >> 4) * 2048 + (tid & 15) * 16), voff = (unsigned)((tid >> 3) * (SEQ * 2) + (tid & 7) * 16);
#define ATT_LOAD(KT) { const char* kb_ = (const char*)(kg + (size_t)(KT) * 64 * 1024); const char* vb_ = (const char*)(vg + (KT) * 64); \
            _Pragma("unroll") for (int j = 0; j < 4; ++j) { \
            kreg[j] = *(const u32x4*)(kb_ + (koff + (unsigned)j * 32768u)); \
            vreg[j] = *(const u32x4*)(vb_ + (voff + (unsigned)j * (32u * SEQ * 2u))); } }
#define ATT_STORE(BUF) _Pragma("unroll") for (int j = 0; j < 4; ++j) { const int id = tid + 256 * j; \
            *(u32x4*)(Kt + (BUF) * ATT_STAGE + (id >> 4) * LDK + (id & 15) * 8) = kreg[j]; \
            u32x2* d = (u32x2*)(Vs + (BUF) * ATT_STAGE + (id >> 3) * LDV + (id & 7) * 8); \
            d[0] = (u32x2){vreg[j].x, vreg[j].y}; d[1] = (u32x2){vreg[j].z, vreg[j].w}; }
#define ATT_ITEM_LOADS(IT) { const int qt_ = (IT) & 31, hd_ = ((IT) >> 5) & 3, b_ = (IT) >> 7; \
            const u16* qp = QK + (size_t)(b_ * SEQ + qt_ * 64 + qg * 32 + r) * 1024 + hd_ * 128 + c * 64 + 8 * h; \
            _Pragma("unroll") for (int ks = 0; ks < 4; ++ks) qfr[ks] = *(const bf16x8*)(qp + ks * 16); \
            kg = QK + (size_t)(b_ * SEQ) * 1024 + 512 + hd_ * 128; \
            vg = VT + (size_t)(b_ * 4 + hd_) * 128 * SEQ; \
            ATT_LOAD(0) }
    if (bid < NB * 4 * 32) ATT_ITEM_LOADS(bid)
    for (int it = bid; it < NB * 4 * 32; it += nb) {
        const int qt = it & 31, hd = (it >> 5) & 3, b = it >> 7;
        const int q0 = qt * 64 + qg * 32;
        const float slope2 = exp2f(-2.f * (hd + 1)) * LOG2E;
        __syncthreads();
        ATT_STORE(0)
        ATT_LOAD(1)
        f32x16 O[4];
#pragma unroll
        for (int dt = 0; dt < 4; ++dt)
#pragma unroll
            for (int i = 0; i < 16; ++i) O[dt][i] = 0.f;
        float lsum = 0.f;
#pragma unroll 1
        for (int kt = 0; kt < SEQ / 64; ++kt) {
            __syncthreads();
            const int cur = kt & 1;
            if (kt + 1 < SEQ / 64) { ATT_STORE(cur ^ 1) }
            if (kt + 2 < SEQ / 64) { ATT_LOAD(kt + 2) }
            const u16* Kc = Kt + cur * ATT_STAGE; const u16* Vc = Vs + cur * ATT_STAGE;
#pragma unroll
            for (int sub = 0; sub < 2; ++sub) {
                const int k0 = kt * 64 + sub * 32;
                const float fd0 = (float)(q0 + r - (k0 + 4 * h));
                const bool diag = (k0 == q0 - (q0 & 31));
                const float ss = (q0 > k0) ? slope2 : -slope2;
                f32x16 S;
                if (diag) {
#pragma unroll
                    for (int i = 0; i < 16; ++i) S[i] = -M2;
                } else {
                    const float A = __builtin_fmaf(-ss, fd0, -M2);
#pragma unroll
                    for (int i = 0; i < 16; ++i) S[i] = __builtin_fmaf(ss, (float)((i & 3) + 8 * (i >> 2)), A);
                }
#pragma unroll
                for (int ks = 0; ks < 4; ++ks) {
                    const bf16x8 kf = *(const bf16x8*)(Kc + (sub * 32 + r) * LDK + c * 64 + ks * 16 + 8 * h);
                    S = MFMA32(kf, qfr[ks], S);
                }
                float pv[16];
                if (diag) {
#pragma unroll
                    for (int i = 0; i < 16; ++i) {
                        const float t = fd0 - (float)((i & 3) + 8 * (i >> 2));
                        pv[i] = __builtin_amdgcn_exp2f(S[i] - slope2 * fabsf(t));
                    }
                } else {
#pragma unroll
                    for (int i = 0; i < 16; ++i) pv[i] = __builtin_amdgcn_exp2f(S[i]);
                }
#pragma unroll
                for (int i = 0; i < 16; ++i) lsum += pv[i];
                bf16x8 pa[2];
#pragma unroll
                for (int s = 0; s < 2; ++s) {
                    u32x4 cv;
#pragma unroll
                    for (int j = 0; j < 4; ++j) cv[j] = pack2(pv[8 * s + 2 * j], pv[8 * s + 2 * j + 1]);
                    pa[s] = __builtin_bit_cast(bf16x8, cv);
                }
#pragma unroll
                for (int s = 0; s < 2; ++s)
#pragma unroll
                    for (int dt = 0; dt < 4; ++dt) {
                        const u16* vp = Vc + (dt * 32 + r) * LDV + sub * 32 + 16 * s + 4 * h;
                        const u32x2 vlo = *(const u32x2*)(vp), vhi = *(const u32x2*)(vp + 8);
                        const bf16x8 vb = __builtin_bit_cast(bf16x8, (u32x4){vlo.x, vlo.y, vhi.x, vhi.y});
                        O[dt] = MFMA32(pa[s], vb, O[dt]);
                    }
            }
        }
        if (it + nb < NB * 4 * 32) ATT_ITEM_LOADS(it + nb)
        lsum += __shfl_xor(lsum, 32);
        const float il = (c == 0) ? 1.f / lsum : lam / lsum;
#pragma unroll
        for (int i = 0; i < 16; ++i) {
            const float a = __shfl(il, crow(i, h));
#pragma unroll
            for (int dt = 0; dt < 4; ++dt) O[dt][i] *= a;
        }
        __syncthreads();
        if (c == 1) {
#pragma unroll
            for (int dt = 0; dt < 4; ++dt)
#pragma unroll
                for (int i = 0; i < 16; ++i) exch[((qg * 4 + dt) * 16 + i) * 64 + lane] = O[dt][i];
        }
        __syncthreads();
        if (c == 0) {
            float gsub[4];
#pragma unroll
            for (int dt = 0; dt < 4; ++dt) gsub[dt] = p.subln_g[dt * 32 + r] * 0.8f;
#pragma unroll
            for (int i = 0; i < 16; ++i) {
                float o[4], ss = 0.f;
#pragma unroll
                for (int dt = 0; dt < 4; ++dt) { o[dt] = O[dt][i] - exch[((qg * 4 + dt) * 16 + i) * 64 + lane]; ss += o[dt] * o[dt]; }
                ss = half_sum(ss);
                const float rn = rsqrtf(ss * (1.f / 128.f) + 1e-6f);
                u16* dst = (u16*)((char*)p.out + OUT_ATT) + (size_t)(b * SEQ + q0 + crow(i, h)) * 512 + hd * 128 + r;
#pragma unroll
                for (int dt = 0; dt < 4; ++dt) dst[dt * 32] = f2bf(o[dt] * rn * gsub[dt]);
            }
        }
    }
}

struct ScanBuf { float kk[16][64], dec[16][64], bb[16][64], kd[16][64], rr[16][64], vv[16][16]; };
struct ScanRegs { u32x2 rs, ks, aa; f32x4 dec; float invn; u16 v; };
DI void scan_load(ScanRegs& g, const Params& p, int b, int hd, int dir, int rg, int chunk) {
    const int tid = threadIdx.x, s = tid >> 4, kq = tid & 15;
    const int t = dir ? (SEQ - 1 - (chunk * 16 + s)) : (chunk * 16 + s);
    const size_t tok = (size_t)b * SEQ + t;
    const size_t off = tok * 512 + hd * 64 + 4 * kq;
    g.rs = *(const u32x2*)((const u16*)(p.ws + OFF_RS) + off);
    g.ks = *(const u32x2*)((const u16*)(p.ws + OFF_KS) + off);
    g.aa = *(const u32x2*)((const u16*)(p.ws + OFF_AA) + (size_t)dir * NTOK * 512 + off);
    g.dec = *(const f32x4*)((const float*)(p.ws + OFF_DEC) + (size_t)dir * NTOK * 512 + off);
    g.invn = ((const float*)(p.ws + OFF_INVN))[tok * 8 + hd];
    g.v = ((const u16*)(p.ws + OFF_VS))[tok * 512 + hd * 64 + rg * 16 + kq];
}
DI void scan_store(const ScanRegs& g, ScanBuf* sb, const f32x4& kkc, const f32x4& kac) {
    const int tid = threadIdx.x, s = tid >> 4, kq = tid & 15;
    const float k0 = bflo(g.ks.x), k1 = bfhi(g.ks.x), k2 = bflo(g.ks.y), k3 = bfhi(g.ks.y);
    const float a0 = bflo(g.aa.x), a1 = bfhi(g.aa.x), a2 = bflo(g.aa.y), a3 = bfhi(g.aa.y);
    f32x4 kk, bb, kd, rr;
    kk.x = k0 * kkc.x * g.invn; kk.y = k1 * kkc.y * g.invn; kk.z = k2 * kkc.z * g.invn; kk.w = k3 * kkc.w * g.invn;
    bb.x = kk.x * a0; bb.y = kk.y * a1; bb.z = kk.z * a2; bb.w = kk.w * a3;
    kd.x = k0 * (1.f + (a0 - 1.f) * kac.x); kd.y = k1 * (1.f + (a1 - 1.f) * kac.y);
    kd.z = k2 * (1.f + (a2 - 1.f) * kac.z); kd.w = k3 * (1.f + (a3 - 1.f) * kac.w);
    rr.x = bflo(g.rs.x); rr.y = bfhi(g.rs.x); rr.z = bflo(g.rs.y); rr.w = bfhi(g.rs.y);
    *(f32x4*)&sb->kk[s][4 * kq] = kk; *(f32x4*)&sb->dec[s][4 * kq] = g.dec; *(f32x4*)&sb->bb[s][4 * kq] = bb;
    *(f32x4*)&sb->kd[s][4 * kq] = kd; *(f32x4*)&sb->rr[s][4 * kq] = rr;
    sb->vv[s][kq] = bf2f(g.v);
}
DI void ph3(const Params& p, char* smem, int bid, int nb) {
    const int tid = threadIdx.x, lane = tid & 63, wave = tid >> 6;
    ScanBuf* sb = (ScanBuf*)smem;
    const int rl = lane >> 4, kq = lane & 15, row = wave * 4 + rl;
    for (int it = bid; it < 512; it += nb) {
        const int rg = it & 3, chain = it >> 2, dir = chain & 1, hd = (chain >> 1) & 7, b = chain >> 4;
        const int ld_kq = tid & 15;
        const f32x4 kkc = *(const f32x4*)(p.k_k + hd * 64 + 4 * ld_kq), kac = *(const f32x4*)(p.k_a + hd * 64 + 4 * ld_kq);
        u16* Y = (u16*)(p.ws + (dir ? OFF_YB : OFF_YF));
        f32x4 st = {0.f, 0.f, 0.f, 0.f};
        ScanRegs g;
        __syncthreads();
        scan_load(g, p, b, hd, dir, rg, 0);
        scan_store(g, &sb[0], kkc, kac);
        __syncthreads();
        for (int ch = 0; ch < SEQ / 16; ++ch) {
            const ScanBuf* cur = &sb[ch & 1];
            if (ch + 1 < SEQ / 16) scan_load(g, p, b, hd, dir, rg, ch + 1);
            float ykeep = 0.f;
#pragma unroll
            for (int s = 0; s < 16; ++s) {
                const f32x4 kk = *(const f32x4*)&cur->kk[s][4 * kq];
                const f32x4 dc = *(const f32x4*)&cur->dec[s][4 * kq];
                const f32x4 bb = *(const f32x4*)&cur->bb[s][4 * kq];
                const f32x4 kd = *(const f32x4*)&cur->kd[s][4 * kq];
                const f32x4 rr = *(const f32x4*)&cur->rr[s][4 * kq];
                const float v = cur->vv[s][row];
                float yp = 0.f;
                if (dir) yp = add_(fma_(st.x, rr.x, mul_(st.y, rr.y)), fma_(st.z, rr.z, mul_(st.w, rr.w)));
                const float sa = -row16_sum(add_(fma_(st.x, kk.x, mul_(st.y, kk.y)), fma_(st.z, kk.z, mul_(st.w, kk.w))));
                st.x = fma_(sa, bb.x, fma_(st.x, dc.x, mul_(v, kd.x)));
                st.y = fma_(sa, bb.y, fma_(st.y, dc.y, mul_(v, kd.y)));
                st.z = fma_(sa, bb.z, fma_(st.z, dc.z, mul_(v, kd.z)));
                st.w = fma_(sa, bb.w, fma_(st.w, dc.w, mul_(v, kd.w)));
                if (!dir) yp = add_(fma_(st.x, rr.x, mul_(st.y, rr.y)), fma_(st.z, rr.z, mul_(st.w, rr.w)));
                const float y = row16_sum(yp);
                ykeep = (kq == s) ? y : ykeep;
            }
            if (ch + 1 < SEQ / 16) scan_store(g, &sb[(ch + 1) & 1], kkc, kac);
            {
                const int t = dir ? (SEQ - 1 - (ch * 16 + kq)) : (ch * 16 + kq);
                Y[((size_t)b * SEQ + t) * 512 + hd * 64 + rg * 16 + row] = f2bf(ykeep);
            }
            __syncthreads();
        }
    }
}

constexpr int C4_A1 = 0, C4_A1SZ = 5632;
constexpr int C4_SETB = 16896, C4_SETBSZ = 8448;
constexpr int C4_VT = 5120, C4_G16 = 8192;
constexpr int C4_LK = 50688, C4_LR = 55296, C4_LKSZ = 2304;
constexpr int C4_LBKR = 62208, C4_LBKRSZ = 4608;
constexpr int C4_M4 = 71424, C4_M4SZ = 4096;
constexpr int C4_TOTAL = 79616;
typedef int i32x4_t __attribute__((ext_vector_type(4)));
#define C4_COEF(V4, S, T) __builtin_bit_cast(float, __builtin_amdgcn_readlane(V4[(T) & 3], 4 * (S) + ((T) >> 2)))
#define C4_MU(T) (((T) & 3) + 8 * (((T) >> 2) & 1) + 4 * ((T) >> 3))
struct C4Raw { unsigned ks[16], rs[16], vs[16], aa[16], dc[16]; int inv; };
DI void c4_load_step(C4Raw& w, const Params& p, int dir, unsigned tokb, unsigned lane2, int j) {
    const char* RS = (const char*)(p.ws + OFF_RS); const char* KS = (const char*)(p.ws + OFF_KS); const char* VS = (const char*)(p.ws + OFF_VS);
    const char* AA = (const char*)(p.ws + OFF_AA + (size_t)dir * NTOK * 512 * 2);
    const char* DEC = (const char*)(p.ws + OFF_DEC + (size_t)dir * NTOK * 512 * 2);
    const unsigned o2 = tokb + lane2;
    w.ks[j] = *(const u16*)(KS + o2); w.rs[j] = *(const u16*)(RS + o2); w.vs[j] = *(const u16*)(VS + o2); w.aa[j] = *(const u16*)(AA + o2);
    w.dc[j] = *(const u16*)(DEC + o2);
}
DI unsigned c4_tokb0(int b, int hd, int dir, int c1) {
    return (unsigned)(b * SEQ + (dir ? (SEQ - 1 - 16 * c1) : 16 * c1)) * 1024u + (unsigned)(hd * 128);
}
DI int c4_load_inv(const Params& p, int b, int hd, int dir, int c1, int lane) {
    const int* INVN = (const int*)(p.ws + OFF_INVN);
    const int st = 16 * c1 + (lane & 15);
    const unsigned tok = (unsigned)(b * SEQ + (dir ? (SEQ - 1 - st) : st));
    return INVN[tok * 8u + (unsigned)hd];
}
DI void c4_x(C4Raw& w, const Params& p, char* smem, int cx, int b, int hd, int dir, int lane, float kkc, float kac) {
    asm volatile("" : "+v"(lane));
    u16* LK = (u16*)(smem + C4_LK + (cx & 1) * C4_LKSZ); u16* LR = (u16*)(smem + C4_LR + (cx % 3) * C4_LKSZ);
    u16* LBKR = (u16*)(smem + C4_LBKR + (cx & 1) * C4_LBKRSZ);
    char* setb = smem + C4_SETB + (cx & 3) * C4_SETBSZ;
    u16* LBKT = (u16*)setb; u16* VT = (u16*)(setb + C4_VT); float* G16 = (float*)(setb + C4_G16);
    const int cn = (cx + 1 < SEQ / 16) ? cx + 1 : cx;
    const int invv = w.inv;
    const int inv_next = c4_load_inv(p, b, hd, dir, cn, lane);
    const unsigned lane2 = 2u * (unsigned)lane;
    unsigned tb = c4_tokb0(b, hd, dir, cn);
    const unsigned tstep = dir ? (unsigned)-1024 : 1024u;
    float G = 1.f;
#pragma unroll
    for (int j = 0; j < 16; j += 2) {
        float nb_[2], kd_[2];
#pragma unroll
        for (int e = 0; e < 2; ++e) {
            const int s = j + e;
            asm volatile("" : "+v"(w.ks[s]), "+v"(w.aa[s]), "+v"(w.rs[s]), "+v"(w.vs[s]), "+v"(w.dc[s]) : "v"(G));
            const float kf = __uint_as_float(w.ks[s] << 16), af = __uint_as_float(w.aa[s] << 16), rf = __uint_as_float(w.rs[s] << 16);
            const float inv = __builtin_bit_cast(float, __builtin_amdgcn_readlane(invv, s));
            const float kkv = kf * kkc * inv;
            const float bbv = kkv * af;
            const float kdv = kf * __builtin_fmaf(af, kac, 1.f - kac);
            const float kt = kkv * G;
            const float Gb = G;
            G *= 1.f - __uint_as_float(w.dc[s] << 16);
            const float rsel = rf * (dir ? Gb : G);
            const float ig = __builtin_amdgcn_rcpf(G);
            float ig2 = ig; asm volatile("" : "+v"(ig2));
            const float bt = bbv * ig, kdt = kdv * ig2;
            const unsigned pkr = pack2(kt, rsel), pbk = pack2(bt, kdt);
            LK[s * 72 + lane] = (u16)pkr;
            LR[s * 72 + lane] = (u16)(pkr >> 16);
            LBKR[s * 72 + lane] = (u16)pbk;
            LBKR[(16 + s) * 72 + lane] = (u16)(pbk >> 16);
            nb_[e] = -bt; kd_[e] = kdt;
        }
        *(unsigned*)(LBKT + lane * 40 + j) = pack2(nb_[0], nb_[1]);
        *(unsigned*)(LBKT + lane * 40 + 16 + j) = pack2(kd_[0], kd_[1]);
        *(unsigned*)(VT + lane * 24 + j) = w.vs[j] | (w.vs[j + 1] << 16);
        c4_load_step(w, p, dir, tb, lane2, j); tb += tstep;
        c4_load_step(w, p, dir, tb, lane2, j + 1); tb += tstep;
    }
    G16[lane] = G;
    w.inv = inv_next;
}
DI void c4_y(char* smem, int cy, int dir, int lane) {
    asm volatile("" : "+v"(lane));
    const u16* LK = (const u16*)(smem + C4_LK + (cy & 1) * C4_LKSZ); const u16* LR = (const u16*)(smem + C4_LR + (cy % 3) * C4_LKSZ);
    const u16* LBKR = (const u16*)(smem + C4_LBKR + (cy & 1) * C4_LBKRSZ);
    float* M4 = (float*)(smem + C4_M4 + (cy & 1) * C4_M4SZ);
    u16* A1 = (u16*)(smem + C4_A1 + (cy % 3) * C4_A1SZ);
    const int r = lane & 31, h = lane >> 5;
    {
        f32x16 acc;
#pragma unroll
        for (int i = 0; i < 16; ++i) acc[i] = 0.f;
        const u16* brow = (r < 16) ? (LK + r * 72) : (LR + (r - 16) * 72);
#pragma unroll
        for (int ks = 0; ks < 4; ++ks) {
            const bf16x8 a = *(const bf16x8*)(LBKR + r * 72 + ks * 16 + 8 * h);
            const bf16x8 bq = *(const bf16x8*)(brow + ks * 16 + 8 * h);
            acc = MFMA32(a, bq, acc);
        }
        const int t = r & 15, lim = t + (((r >> 4) & (dir ^ 1)));
        float* dst = M4 + (r >> 4) * 256 + t + 4 * h * 16;
#pragma unroll
        for (int i = 0; i < 16; ++i) {
            const int s0 = (i & 3) + 8 * ((i >> 2) & 1);
            dst[(i >> 3) * 512 + s0 * 16] = (s0 + 4 * h < lim) ? acc[i] : 0.f;
        }
    }
    __builtin_amdgcn_s_waitcnt(0xc07f); asm volatile("" ::: "memory");
    f32x2_t kp[16];
#pragma unroll
    for (int t = 0; t < 16; ++t) kp[t].x = bf2f(LK[t * 72 + lane]);
#pragma unroll
    for (int q = 0; q < 4; ++q) {
        const f32x4 m = *(const f32x4*)(M4 + 512 + (lane & 15) * 16 + 4 * q);
        kp[4 * q].y = m.x; kp[4 * q + 1].y = m.y; kp[4 * q + 2].y = m.z; kp[4 * q + 3].y = m.w;
    }
    {
        f32x4 cf[2][4];
#pragma unroll
        for (int q = 0; q < 4; ++q) cf[0][q] = *(const f32x4*)(M4 + 4 * q);
#pragma unroll
        for (int s2 = 0; s2 < 15; ++s2) {
            if (s2 + 1 < 15) {
                int off = 0; asm volatile("" : "+v"(off) : "v"(kp[s2].x));
                const float* rowp = M4 + off + (s2 + 1) * 16;
#pragma unroll
                for (int q = (s2 + 2) >> 2; q < 4; ++q) cf[(s2 + 1) & 1][q] = *(const f32x4*)(rowp + 4 * q);
            }
            const f32x2_t sp = kp[s2];
#pragma unroll
            for (int t = s2 + 1; t < 16; ++t) {
                const float c = -cf[s2 & 1][t >> 2][t & 3];
                kp[t] = __builtin_elementwise_fma((f32x2_t){c, c}, sp, kp[t]);
            }
        }
    }
    const int pos = (lane & 0x30) | ((lane & 4) << 1) | ((lane & 8) >> 1) | (lane & 3);
    u16* A1p = A1 + 64 + (lane & 15);
    if (lane >= 16) A1p = A1 + 80 + (lane & 7);
#pragma unroll
    for (int t = 0; t < 16; ++t) {
        const unsigned pk = pack2(kp[t].x, kp[t].y);
        A1[C4_MU(t) * 88 + pos] = (u16)pk; A1p[C4_MU(t) * 88] = (u16)(pk >> 16);
    }
}
DI void c4_z(char* smem, int cz, int lane) {
    asm volatile("" : "+v"(lane));
    const u16* LR = (const u16*)(smem + C4_LR + (cz % 3) * C4_LKSZ);
    const float* M4 = (const float*)(smem + C4_M4 + (cz & 1) * C4_M4SZ);
    u16* A1 = (u16*)(smem + C4_A1 + (cz % 3) * C4_A1SZ);
    const int pos = (lane & 0x30) | ((lane & 4) << 1) | ((lane & 8) >> 1) | (lane & 3);
    f32x2_t kp[16], rq[16];
#pragma unroll
    for (int t = 0; t < 16; ++t) {
        kp[t].x = bf2f(A1[C4_MU(t) * 88 + pos]); kp[t].y = bf2f(A1[C4_MU(t) * 88 + 64 + (lane & 15)]);
        rq[t].x = bf2f(LR[t * 72 + lane]);
    }
#pragma unroll
    for (int q = 0; q < 4; ++q) {
        const f32x4 m = *(const f32x4*)(M4 + 768 + (lane & 15) * 16 + 4 * q);
        rq[4 * q].y = m.x; rq[4 * q + 1].y = m.y; rq[4 * q + 2].y = m.z; rq[4 * q + 3].y = m.w;
    }
    {
        f32x4 cf[2][4];
#pragma unroll
        for (int q = 0; q < 4; ++q) cf[0][q] = *(const f32x4*)(M4 + 256 + 4 * q);
#pragma unroll
        for (int s2 = 0; s2 < 16; ++s2) {
            if (s2 + 1 < 16) {
                int off = 0; asm volatile("" : "+v"(off) : "v"(rq[s2].x));
                const float* rowp = M4 + 256 + off + (s2 + 1) * 16;
#pragma unroll
                for (int q = (s2 + 1) >> 2; q < 4; ++q) cf[(s2 + 1) & 1][q] = *(const f32x4*)(rowp + 4 * q);
            }
#pragma unroll
            for (int t = s2; t < 16; ++t) {
                const float c = -cf[s2 & 1][t >> 2][t & 3];
                rq[t] = __builtin_elementwise_fma((f32x2_t){c, c}, kp[s2], rq[t]);
            }
        }
    }
    u16* A1p = A1 + 64 + (lane & 15);
    if (lane >= 16) A1p = A1 + 80 + (lane & 7);
#pragma unroll
    for (int t = 0; t < 16; ++t) {
        const unsigned pk = pack2(rq[t].x, rq[t].y);
        A1[(16 + C4_MU(t)) * 88 + pos] = (u16)pk; A1p[(16 + C4_MU(t)) * 88] = (u16)(pk >> 16);
    }
}
#define C4_PACKB(S, SP) __builtin_bit_cast(bf16x8, (u32x4){pack2(S[8 * (SP)], S[8 * (SP) + 1]), pack2(S[8 * (SP) + 2], S[8 * (SP) + 3]), \
                                                             pack2(S[8 * (SP) + 4], S[8 * (SP) + 5]), pack2(S[8 * (SP) + 6], S[8 * (SP) + 7])})
DI void ph3c_chain(const Params& p, char* smem, int chain) {
    const int tid = threadIdx.x, lane = tid & 63, wave = __builtin_amdgcn_readfirstlane(tid >> 6);
    const int dir = chain & 1, hd = (chain >> 1) & 7, b = chain >> 4;
    constexpr int NCH = SEQ / 16;
    __syncthreads();
    if (wave == 1) {
        C4Raw raw;
#pragma unroll
        for (int j = 0; j < 16; ++j) c4_load_step(raw, p, dir, c4_tokb0(b, hd, dir, 0) + (unsigned)j * (dir ? (unsigned)-1024 : 1024u), 2u * (unsigned)lane, j);
        raw.inv = c4_load_inv(p, b, hd, dir, 0, lane);
        const float kkc = p.k_k[hd * 64 + lane], kac = p.k_a[hd * 64 + lane];
        __builtin_amdgcn_s_waitcnt(0x0f70);
#pragma unroll 1
        for (int i = -3; i < NCH; ++i) {
            if (i + 3 < NCH) c4_x(raw, p, smem, i + 3, b, hd, dir, lane, kkc, kac);
            __syncthreads();
        }
    } else if (wave == 2) {
#pragma unroll 1
        for (int i = -3; i < NCH; ++i) {
            if (i + 2 >= 0 && i + 2 < NCH) c4_y(smem, i + 2, dir, lane);
            __syncthreads();
        }
    } else if (wave == 3) {
#pragma unroll 1
        for (int i = -3; i < NCH; ++i) {
            if (i + 1 >= 0 && i + 1 < NCH) c4_z(smem, i + 1, lane);
            __syncthreads();
        }
    } else {
        __syncthreads(); __syncthreads(); __syncthreads();
        f32x16 s00, s01, s10, s11;
#pragma unroll
        for (int i = 0; i < 16; ++i) { s00[i] = 0.f; s01[i] = 0.f; s10[i] = 0.f; s11[i] = 0.f; }
        u16* Y = (u16*)(p.ws + OFF_YF);
        const int r_ = lane & 31, h_ = lane >> 5;
#pragma unroll 1
        for (int c = 0; c < NCH; ++c) {
            int cc = c; asm volatile("" : "+s"(cc));
            int r = r_, h = h_; asm volatile("" : "+v"(r), "+v"(h));
            const u16* A1 = (const u16*)(smem + C4_A1 + (cc % 3) * C4_A1SZ);
            const char* setb = smem + C4_SETB + (cc & 3) * C4_SETBSZ;
            const u16* LBKT = (const u16*)setb; const u16* VT = (const u16*)(setb + C4_VT); const float* G16 = (const float*)(setb + C4_G16);
            const bf16x8 aq0 = *(const bf16x8*)(A1 + r * 88 + 8 * h), aq1 = *(const bf16x8*)(A1 + r * 88 + 16 + 8 * h);
            const bf16x8 aq2 = *(const bf16x8*)(A1 + r * 88 + 32 + 8 * h), aq3 = *(const bf16x8*)(A1 + r * 88 + 48 + 8 * h);
            const bf16x8 ap = *(const bf16x8*)(A1 + r * 88 + 64 + 8 * h);
            const bf16x8 vb0 = *(const bf16x8*)(VT + r * 24 + 8 * h), vb1 = *(const bf16x8*)(VT + (32 + r) * 24 + 8 * h);
            f32x16 xy0, xy1;
#pragma unroll
            for (int i = 0; i < 16; ++i) { xy0[i] = 0.f; xy1[i] = 0.f; }
            xy0 = MFMA32(aq0, C4_PACKB(s00, 0), xy0); xy1 = MFMA32(aq0, C4_PACKB(s01, 0), xy1);
            xy0 = MFMA32(aq1, C4_PACKB(s00, 1), xy0); xy1 = MFMA32(aq1, C4_PACKB(s01, 1), xy1);
            xy0 = MFMA32(aq2, C4_PACKB(s10, 0), xy0); xy1 = MFMA32(aq2, C4_PACKB(s11, 0), xy1);
            xy0 = MFMA32(aq3, C4_PACKB(s10, 1), xy0); xy1 = MFMA32(aq3, C4_PACKB(s11, 1), xy1);
            xy0 = MFMA32(ap, vb0, xy0); xy1 = MFMA32(ap, vb1, xy1);
            const bf16x8 ub0 = C4_PACKB(xy0, 0), ub1 = C4_PACKB(xy1, 0);
            {
                const bf16x8 l00 = *(const bf16x8*)(LBKT + r * 40 + 8 * h), l01 = *(const bf16x8*)(LBKT + r * 40 + 16 + 8 * h);
                const bf16x8 l10 = *(const bf16x8*)(LBKT + (32 + r) * 40 + 8 * h), l11 = *(const bf16x8*)(LBKT + (32 + r) * 40 + 16 + 8 * h);
                s00 = MFMA32(l00, ub0, s00); s01 = MFMA32(l00, ub1, s01); s10 = MFMA32(l10, ub0, s10); s11 = MFMA32(l10, ub1, s11);
                s00 = MFMA32(l01, vb0, s00); s01 = MFMA32(l01, vb1, s01); s10 = MFMA32(l11, vb0, s10); s11 = MFMA32(l11, vb1, s11);
            }
            {
                const unsigned vst = (unsigned)(dir * NTOK * 512 + hd * 64 + r);
#pragma unroll
                for (int j = 0; j < 8; ++j) {
                    const int stp = 16 * cc + 8 * h + j;
                    const unsigned tok = (unsigned)(b * SEQ + (dir ? (SEQ - 1 - stp) : stp));
                    Y[tok * 512u + vst] = f2bf(xy0[8 + j]);
                    Y[tok * 512u + vst + 32u] = f2bf(xy1[8 + j]);
                }
            }
#pragma unroll
            for (int g4 = 0; g4 < 4; ++g4) {
                const f32x4 ga = *(const f32x4*)(G16 + 8 * g4 + 4 * h), gb = *(const f32x4*)(G16 + 32 + 8 * g4 + 4 * h);
                s00[4 * g4 + 0] *= ga.x; s00[4 * g4 + 1] *= ga.y; s00[4 * g4 + 2] *= ga.z; s00[4 * g4 + 3] *= ga.w;
                s01[4 * g4 + 0] *= ga.x; s01[4 * g4 + 1] *= ga.y; s01[4 * g4 + 2] *= ga.z; s01[4 * g4 + 3] *= ga.w;
                s10[4 * g4 + 0] *= gb.x; s10[4 * g4 + 1] *= gb.y; s10[4 * g4 + 2] *= gb.z; s10[4 * g4 + 3] *= gb.w;
                s11[4 * g4 + 0] *= gb.x; s11[4 * g4 + 1] *= gb.y; s11[4 * g4 + 2] *= gb.z; s11[4 * g4 + 3] *= gb.w;
            }
            __syncthreads();
        }
    }
}

DI void ph4(const Params& p, int bid, int nb) {
    const u16* YF = (const u16*)(p.ws + OFF_YF); const u16* YB = (const u16*)(p.ws + OFF_YB);
    const u16* G = (const u16*)(p.ws + OFF_G); const u16* VS = (const u16*)(p.ws + OFF_VS); const float* RKR = (const float*)(p.ws + OFF_BONUS);
    u16* RWOUT = (u16*)(p.ws + OFF_RWOUT);
#pragma unroll 2
    for (int e = bid * 256 + threadIdx.x; e < NTOK * 64; e += nb * 256) {
        const int tok = e >> 6, c = (e & 63) * 8;
        float yf[8], yb[8], g[8], bo[8], y[8];
        load8(YF + (size_t)tok * 512 + c, yf); load8(YB + (size_t)tok * 512 + c, yb);
        load8(G + (size_t)tok * 512 + c, g); load8(VS + (size_t)tok * 512 + c, bo);
        { const float rkr = RKR[tok * 8 + (c >> 6)];
#pragma unroll
          for (int j = 0; j < 8; ++j) bo[j] *= rkr; }
        float s = 0.f;
#pragma unroll
        for (int j = 0; j < 8; ++j) { y[j] = yf[j] + yb[j]; s += y[j]; }
        const float mean = grp8_sum(s) * (1.f / 64.f);
        float vs = 0.f;
#pragma unroll
        for (int j = 0; j < 8; ++j) { const float d = y[j] - mean; vs += d * d; }
        const float var = grp8_sum(vs) * (1.f / 64.f);
        const float rn = rsqrtf(var + 64e-5f);
        const f32x4 ga = *(const f32x4*)(p.ln_g + c), gb = *(const f32x4*)(p.ln_g + c + 4);
        const f32x4 ba = *(const f32x4*)(p.ln_b + c), bb = *(const f32x4*)(p.ln_b + c + 4);
        const float lg[8] = {ga.x, ga.y, ga.z, ga.w, gb.x, gb.y, gb.z, gb.w};
        const float lb[8] = {ba.x, ba.y, ba.z, ba.w, bb.x, bb.y, bb.z, bb.w};
        float o[8];
#pragma unroll
        for (int j = 0; j < 8; ++j) o[j] = ((y[j] - mean) * rn * lg[j] + lb[j] + bo[j]) * g[j];
        store8(RWOUT + (size_t)tok * 512 + c, o);
    }
}


DI unsigned pk4_fp8(float a, float b, float c, float d) {
    int w = 0;
    w = __builtin_amdgcn_cvt_pk_fp8_f32(a, b, w, false);
    w = __builtin_amdgcn_cvt_pk_fp8_f32(c, d, w, true);
    return (unsigned)w;
}
DI void convert_fp8_rows(const float* __restrict__ src, unsigned char* __restrict__ dst, unsigned char* __restrict__ dst2, int split, float* __restrict__ scales, int bid, int nb) {
    const int lane = threadIdx.x & 63, wave = threadIdx.x >> 6;
    for (int row = bid * 4 + wave; row < 16384; row += nb * 4) {
        const f32x4* sp = (const f32x4*)(src + (size_t)row * 1024 + 16 * lane);
        const f32x4 v0 = sp[0], v1 = sp[1], v2 = sp[2], v3 = sp[3];
        float m = fmaxf(fmaxf(fabsf(v0.x), fabsf(v0.y)), fmaxf(fabsf(v0.z), fabsf(v0.w)));
        m = fmaxf(m, fmaxf(fmaxf(fabsf(v1.x), fabsf(v1.y)), fmaxf(fabsf(v1.z), fabsf(v1.w))));
        m = fmaxf(m, fmaxf(fmaxf(fabsf(v2.x), fabsf(v2.y)), fmaxf(fabsf(v2.z), fabsf(v2.w))));
        m = fmaxf(m, fmaxf(fmaxf(fabsf(v3.x), fabsf(v3.y)), fmaxf(fabsf(v3.z), fabsf(v3.w))));
        m = wave_max(m);
        const float scale = (m > 0.f) ? m * (1.f / 440.f) : 1.f;
        const float inv = 1.f / scale;
        u32x4 o;
        o.x = pk4_fp8(v0.x * inv, v0.y * inv, v0.z * inv, v0.w * inv);
        o.y = pk4_fp8(v1.x * inv, v1.y * inv, v1.z * inv, v1.w * inv);
        o.z = pk4_fp8(v2.x * inv, v2.y * inv, v2.z * inv, v2.w * inv);
        o.w = pk4_fp8(v3.x * inv, v3.y * inv, v3.z * inv, v3.w * inv);
        *(u32x4*)((row < split ? dst + (size_t)row * 1024 : dst2 + (size_t)(row - split) * 1024) + 16 * lane) = o;
        if (lane == 0) scales[row] = scale;
    }
}

DI void ph5(const Params& p, char* smem, int bid, int nb) {
    const int tid = threadIdx.x, lane = tid & 63, wave = tid >> 6;
    const int wr = wave >> 1, wc = wave & 1, r = lane & 31, h = lane >> 5;
    const u16* ATT = (const u16*)((char*)p.out + OUT_ATT);
    const u16* RWOUT = (const u16*)(p.ws + OFF_RWOUT);
    const u16* WT = (const u16*)(p.ws + OFF_WOUTT);
    const float* mod = (const float*)(p.ws + OFF_MOD);
    u16* X1 = (u16*)(p.ws + OFF_X1); float* ss2p = (float*)(p.ws + OFF_SS2P);
    u16* X1G = (u16*)(p.ws + OFF_X1G);
    int mt, nt;
    for (int rnd = 0; xcd_tile256(bid, nb, rnd, 8, mt, nt); ++rnd) {
      const int n0 = nt * 128;
      f32x16 accs[2][2][2];
#pragma unroll
      for (int hf = 0; hf < 2; ++hf) zero_acc(accs[hf]);
      gemm_bf16A_256(accs, ATT + (size_t)(mt * 256) * 512, 512, WT + (size_t)n0 * 1024, 1024, 8, smem);
      gemm_bf16A_256(accs, RWOUT + (size_t)(mt * 256) * 512, 512, WT + (size_t)n0 * 1024 + 512, 1024, 8, smem);
#pragma unroll
      for (int hf = 0; hf < 2; ++hf) {
        f32x16 (&acc)[2][2] = accs[hf];
        const int m0 = mt * 256 + hf * 128, b = m0 / SEQ;
        const float* gate = mod + b * 6144 + 2048 + n0;
        const float* sc2 = mod + b * 6144 + 4096 + n0;
        float* Fs = (float*)smem;
        __syncthreads();
#pragma unroll
        for (int mi = 0; mi < 2; ++mi)
#pragma unroll
            for (int ni = 0; ni < 2; ++ni)
#pragma unroll
                for (int i = 0; i < 16; ++i)
                    Fs[(wr * 64 + mi * 32 + (i & 3) + 8 * (i >> 2) + 4 * h) * 132 + wc * 64 + ni * 32 + r] = acc[mi][ni][i];
        __syncthreads();
#pragma unroll 4
        for (int j = 0; j < 16; ++j) {
            const int id = tid + 256 * j, row = id >> 5, c4 = id & 31;
            const f32x4 a = *(const f32x4*)(Fs + row * 132 + 4 * c4);
            const size_t go = (size_t)(m0 + row) * DM + n0 + 4 * c4;
            const f32x4 xv = *(const f32x4*)(p.x + go), gv = *(const f32x4*)(gate + 4 * c4);
            const f32x4 ng = *(const f32x4*)(p.norm2_g + n0 + 4 * c4), sv = *(const f32x4*)(sc2 + 4 * c4);
            f32x4 v;
            v.x = xv.x + gv.x * a.x; v.y = xv.y + gv.y * a.y; v.z = xv.z + gv.z * a.z; v.w = xv.w + gv.w * a.w;
            { u32x2 xb; xb.x = pack2(v.x, v.y); xb.y = pack2(v.z, v.w); *(u32x2*)(X1 + go) = xb; }
            u32x2 o; o.x = pack2(v.x * ng.x * (1.f + sv.x), v.y * ng.y * (1.f + sv.y)); o.y = pack2(v.z * ng.z * (1.f + sv.z), v.w * ng.w * (1.f + sv.w));
            *(u32x2*)(X1G + go) = o;
            float ss = v.x * v.x + v.y * v.y + v.z * v.z + v.w * v.w;
            ss = row16_sum(ss);
            ss += dppm<0x142, 0xa>(ss);
            if ((lane & 31) == 31) ss2p[(size_t)(m0 + row) * 8 + nt] = ss;
        }
      }
    }
}

DI unsigned score_key(float s, int idx) {
    unsigned u = __float_as_uint(s);
    u = (u & 0x80000000u) ? ~u : (u | 0x80000000u);
    return (u & ~127u) | (unsigned)idx;
}
DI float key_score(unsigned k) {
    unsigned u = (k & ~127u) | 64u;
    u = (u & 0x80000000u) ? (u & 0x7fffffffu) : ~u;
    return __uint_as_float(u);
}
DI unsigned score_key8(float s, int tag) {
    unsigned u = __float_as_uint(s);
    u = (u & 0x80000000u) ? ~u : (u | 0x80000000u);
    return (u & ~255u) | (unsigned)tag;
}
DI float key_score8(unsigned k) {
    unsigned u = (k & ~255u) | 128u;
    u = (u & 0x80000000u) ? (u & 0x7fffffffu) : ~u;
    return __uint_as_float(u);
}
constexpr int LDS_S = 136;
constexpr int SMEM_RS_OFF = 79616 - 512;
template <int B> DI void sort16_desc(unsigned (&c)[64]) {
#pragma unroll
    for (int k = 2; k <= 16; k <<= 1)
#pragma unroll
        for (int j = k >> 1; j > 0; j >>= 1)
#pragma unroll
            for (int i = 0; i < 16; ++i) {
                const int l = i ^ j;
                if (l > i) {
                    const unsigned hi = max(c[B + i], c[B + l]), lo = min(c[B + i], c[B + l]);
                    const bool desc = (i & k) == 0;
                    c[B + i] = desc ? hi : lo; c[B + l] = desc ? lo : hi;
                }
            }
}
DI void bitonic_merge16_desc(unsigned (&t)[16]) {
#pragma unroll
    for (int j = 8; j > 0; j >>= 1)
#pragma unroll
        for (int i = 0; i < 16; ++i) {
            const int l = i ^ j;
            if (l > i) { const unsigned hi = max(t[i], t[l]), lo = min(t[i], t[l]); t[i] = hi; t[l] = lo; }
        }
}
DI void topk_tile(const f32x16 (&acc)[2][2], unsigned* S, unsigned* __restrict__ dst0, int wr, int wc, int r, int h) {
    const int tid = threadIdx.x;
#pragma unroll
    for (int mi = 0; mi < 2; ++mi)
#pragma unroll
        for (int ni = 0; ni < 2; ++ni)
#pragma unroll
            for (int i = 0; i < 16; ++i) {
                const int row = wr * 64 + mi * 32 + crow(i, h), col = wc * 64 + ni * 32 + r;
                S[row * LDS_S + (col >> 6) * 68 + (col & 63)] = score_key(acc[mi][ni][i], col);
            }
    __syncthreads();
    const int row = tid >> 1, half = tid & 1;
    const unsigned* base = S + row * LDS_S + half * 68;
    unsigned c[64];
#pragma unroll
    for (int j = 0; j < 16; ++j) {
        const u32x4 v = *(const u32x4*)(base + 4 * j);
        c[4 * j] = v.x; c[4 * j + 1] = v.y; c[4 * j + 2] = v.z; c[4 * j + 3] = v.w;
    }
    sort16_desc<0>(c); sort16_desc<16>(c); sort16_desc<32>(c); sort16_desc<48>(c);
    unsigned t[16], u[16];
#pragma unroll
    for (int i = 0; i < 16; ++i) { t[i] = max(c[i], c[31 - i]); u[i] = max(c[32 + i], c[63 - i]); }
    bitonic_merge16_desc(t); bitonic_merge16_desc(u);
#pragma unroll
    for (int i = 0; i < 16; ++i) t[i] = max(t[i], u[15 - i]);
    bitonic_merge16_desc(t);
#pragma unroll
    for (int i = 0; i < 16; ++i) u[i] = (unsigned)__builtin_amdgcn_update_dpp(0, (int)t[15 - i], 0xB1, 0xf, 0xf, false);
#pragma unroll
    for (int i = 0; i < 16; ++i) t[i] = max(t[i], u[i]);
    bitonic_merge16_desc(t);
    unsigned* dst = dst0 + (size_t)row * 256 + half * 8;
    *(u32x4*)dst = half ? (u32x4){t[8], t[9], t[10], t[11]} : (u32x4){t[0], t[1], t[2], t[3]};
    *(u32x4*)(dst + 4) = half ? (u32x4){t[12], t[13], t[14], t[15]} : (u32x4){t[4], t[5], t[6], t[7]};
}

DI void ph6(const Params& p, char* smem, int bid, int nb) {
    const int tid = threadIdx.x, lane = tid & 63, wave = tid >> 6;
    const int wr = wave >> 1, wc = wave & 1, r = lane & 31, h = lane >> 5;
    const float* ss2p = (const float*)(p.ws + OFF_SS2P);
    const float* SW = (const float*)(p.ws + OFF_SW);
    const u16* X1G = (const u16*)(p.ws + OFF_X1G);
    const u16* WT = (const u16*)(p.ws + OFF_WQT);
    const u16* KEYS = (const u16*)(p.ws + OFF_KEYS);
    unsigned* TOPK = (unsigned*)(p.ws + OFF_TOPK);
    int mt, nt;
    for (int rnd = 0; xcd_tile256(bid, nb, rnd, 16, mt, nt); ++rnd) {
        const int n0 = nt * 128;
        f32x16 accs[2][2][2];
#pragma unroll
        for (int hf = 0; hf < 2; ++hf) zero_acc(accs[hf]);
        gemm_bf16A_256(accs, X1G + (size_t)(mt * 256) * DM, DM, WT + (size_t)n0 * DM, DM, 16, smem);
#pragma unroll
        for (int hf = 0; hf < 2; ++hf) {
            f32x16 (&acc)[2][2] = accs[hf];
            const int m0 = mt * 256 + hf * 128, b = m0 / SEQ;
            const u16* kb = KEYS + (size_t)nt * 128 * 128 + (size_t)(wc * 64 + r) * 128 + 8 * h;
            bf16x8 kf0[8], kf1[8];
#pragma unroll
            for (int ks = 0; ks < 8; ++ks) { kf0[ks] = *(const bf16x8*)(kb + ks * 16); kf1[ks] = *(const bf16x8*)(kb + 32 * 128 + ks * 16); }
            const float sw0 = SW[b * 2048 + n0 + wc * 64 + r], sw1 = SW[b * 2048 + n0 + wc * 64 + 32 + r];
            float* rsS = (float*)(smem + SMEM_RS_OFF);
            if (tid < 128) rsS[tid] = rsqrtf(ss2_row(ss2p, m0 + tid) * (1.f / 1024.f) + 1e-6f);
            __syncthreads();
#pragma unroll
            for (int mi = 0; mi < 2; ++mi)
#pragma unroll
                for (int i = 0; i < 16; ++i) {
                    const float rs = rsS[wr * 64 + mi * 32 + crow(i, h)];
                    acc[mi][0][i] = acc[mi][0][i] * rs + sw0; acc[mi][1][i] = acc[mi][1][i] * rs + sw1;
                }
            u16* Os = (u16*)smem;
            __syncthreads();
            stage_tile_bf16<false>(Os, acc, wr, wc, r, h);
            __syncthreads();
            zero_acc(acc);
#pragma unroll
            for (int ks = 0; ks < 8; ++ks) {
                const bf16x8 b0 = kf0[ks], b1 = kf1[ks];
                const bf16x8 a0 = *(const bf16x8*)(Os + (wr * 64 + r) * LDO + ks * 16 + 8 * h);
                const bf16x8 a1 = *(const bf16x8*)(Os + (wr * 64 + 32 + r) * LDO + ks * 16 + 8 * h);
                acc[0][0] = MFMA32(a0, b0, acc[0][0]); acc[0][1] = MFMA32(a0, b1, acc[0][1]);
                acc[1][0] = MFMA32(a1, b0, acc[1][0]); acc[1][1] = MFMA32(a1, b1, acc[1][1]);
            }
            __syncthreads();
            topk_tile(acc, (unsigned*)smem, TOPK + ((size_t)m0 * 16 + nt) * 16, wr, wc, r, h);
            __syncthreads();
        }
    }
}

DI float gelu_as(float v) {
    const float av = fabsf(v), d = av * 0.2316418882f + 1.0f;
    const float t = __builtin_amdgcn_rcpf(d);
    float q = t * 0.5307027145f + (-0.7265760135f); q = q * t + 0.7107068705f; q = q * t + (-0.142248368f); q = q * t + 0.127414796f; q = q * t;
    const float e = __builtin_amdgcn_exp2f((v * v) * (-0.72134752044f));
    const float m = v * (q * e), r = v - m;
    return v < 0.f ? m : r;
}
DI float dot16_fp8(const u32x4 u, const float (&h)[16]) {
    float d0 = 0.f, d1 = 0.f;
#pragma unroll
    for (int w = 0; w < 4; ++w) {
        const f32x2_t lo = __builtin_amdgcn_cvt_pk_f32_fp8((int)u[w], false), hi = __builtin_amdgcn_cvt_pk_f32_fp8((int)u[w], true);
        d0 = fma_(lo.x, h[4 * w + 0], d0); d1 = fma_(lo.y, h[4 * w + 1], d1);
        d0 = fma_(hi.x, h[4 * w + 2], d0); d1 = fma_(hi.y, h[4 * w + 3], d1);
    }
    return d0 + d1;
}
DI void axpy16_fp8(float (&acc)[16], const float wgt, const u32x4 v) {
#pragma unroll
    for (int w = 0; w < 4; ++w) {
        const f32x2_t lo = __builtin_amdgcn_cvt_pk_f32_fp8((int)v[w], false), hi = __builtin_amdgcn_cvt_pk_f32_fp8((int)v[w], true);
        acc[4 * w + 0] = fma_(wgt, lo.x, acc[4 * w + 0]); acc[4 * w + 1] = fma_(wgt, lo.y, acc[4 * w + 1]);
        acc[4 * w + 2] = fma_(wgt, hi.x, acc[4 * w + 2]); acc[4 * w + 3] = fma_(wgt, hi.y, acc[4 * w + 3]);
    }
}
DI float wave_total(float x) {
    x = row16_sum(x);
    x += dppm<0x142, 0xa>(x);
    x += dppm<0x143, 0xc>(x);
    return __builtin_bit_cast(float, __builtin_amdgcn_readlane(__builtin_bit_cast(int, x), 63));
}
struct Rows8 { u32x4 r[8]; };
DI void g8_load(Rows8& rw, const unsigned* skey, int g, const unsigned char* T8, const unsigned char* T8hi, int split, int lane) {
#pragma unroll
    for (int q = 0; q < 8; ++q) {
        const int e = (int)__builtin_amdgcn_readfirstlane(skey[(q >> 2) * 128 + 4 * g + (q & 3)]);
        rw.r[q] = *(const u32x4*)((e < split ? T8 : T8hi) + (size_t)e * 1024 + 16 * lane);
    }
}
DI float g8_reduce(const float (&d)[8], int lane) {
    const bool b0 = lane & 1, b1 = lane & 2, b2 = lane & 4;
    float r4[4], s2[2];
#pragma unroll
    for (int j = 0; j < 4; ++j) { const float keep = b0 ? d[j + 4] : d[j], send = b0 ? d[j] : d[j + 4]; r4[j] = keep + dppmov<0xB1>(send); }
#pragma unroll
    for (int j = 0; j < 2; ++j) { const float keep = b1 ? r4[j + 2] : r4[j], send = b1 ? r4[j] : r4[j + 2]; s2[j] = keep + dppmov<0x4E>(send); }
    const float keep = b2 ? s2[1] : s2[0], send = b2 ? s2[0] : s2[1];
    float t = keep + __builtin_bit_cast(float, __builtin_amdgcn_ds_swizzle(__builtin_bit_cast(int, send), 0x101F));
    t += dppmov<0x128>(t);
    t += __builtin_bit_cast(float, __builtin_amdgcn_ds_swizzle(__builtin_bit_cast(int, t), 0x401F));
    t += __shfl_xor(t, 32);
    return t;
}
DI float g8_dot(const u32x4 u, const f32x2_t (&h2)[8]) {
    f32x2_t a0 = {0.f, 0.f}, a1 = {0.f, 0.f};
#pragma unroll
    for (int w = 0; w < 4; ++w) {
        const f32x2_t lo = __builtin_amdgcn_cvt_pk_f32_fp8((int)u[w], false), hi = __builtin_amdgcn_cvt_pk_f32_fp8((int)u[w], true);
        a0 = __builtin_elementwise_fma(lo, h2[2 * w], a0); a1 = __builtin_elementwise_fma(hi, h2[2 * w + 1], a1);
    }
    a0 += a1;
    return a0.x + a0.y;
}
DI void g8_axpy(f32x2_t (&acc)[8], const float wgt, const u32x4 v) {
    const f32x2_t w2 = {wgt, wgt};
#pragma unroll
    for (int w = 0; w < 4; ++w) {
        const f32x2_t lo = __builtin_amdgcn_cvt_pk_f32_fp8((int)v[w], false), hi = __builtin_amdgcn_cvt_pk_f32_fp8((int)v[w], true);
        acc[2 * w] = __builtin_elementwise_fma(w2, lo, acc[2 * w]); acc[2 * w + 1] = __builtin_elementwise_fma(w2, hi, acc[2 * w + 1]);
    }
}
constexpr int TPW = 2;
DI void ph7(const Params& p, char* smem, int bid, int nb) {
    const int tid = threadIdx.x, lane = tid & 63, wave = tid >> 6;
    unsigned* ekey8 = (unsigned*)(smem + wave * 10752);
    float* egate8 = (float*)(ekey8 + 1024);
    unsigned* skey = (unsigned*)(egate8 + 1024); float* sgate = (float*)(skey + 256);
    unsigned* cnt = (unsigned*)(sgate + 256);
    const unsigned* TOPK = (const unsigned*)(p.ws + OFF_TOPK);
    const u16* X1 = (const u16*)(p.ws + OFF_X1);
    const float* ss2p = (const float*)(p.ws + OFF_SS2P);
    const float* mod = (const float*)(p.ws + OFF_MOD);
    const unsigned char* U8 = p.ws + OFF_U8; const unsigned char* V8A = p.ws + OFF_V8A; const unsigned char* V8B = p.ws + OFF_V8B - (size_t)V8_SPLIT * 1024;
    const float* usc = (const float*)(p.ws + OFF_USC); const float* vsc = (const float*)(p.ws + OFF_VSC);
    const int nwaves = nb * 4, gw = bid * 4 + wave;
    for (int tokc = gw * TPW; tokc < NTOK; tokc += 4 * nwaves * TPW) {
      {
          const int slot = lane >> 3, hd = lane & 7;
          const int tok = tokc + (slot >> 1) * nwaves * TPW + (slot & 1);
          if (tok < NTOK) {
              const unsigned* l1 = TOPK + (size_t)tok * 256 + hd * 32; const unsigned* l2 = l1 + 16;
              float s1[16], s2[16];
#pragma unroll
              for (int q = 0; q < 4; ++q) {
                  const u32x4 a = *(const u32x4*)(l1 + 4 * q), bb = *(const u32x4*)(l2 + 4 * q);
                  s1[4 * q] = key_score(a.x); s1[4 * q + 1] = key_score(a.y); s1[4 * q + 2] = key_score(a.z); s1[4 * q + 3] = key_score(a.w);
                  s2[4 * q] = key_score(bb.x); s2[4 * q + 1] = key_score(bb.y); s2[4 * q + 2] = key_score(bb.z); s2[4 * q + 3] = key_score(bb.w);
              }
              unsigned c[64];
#pragma unroll
              for (int n = 0; n < 64; ++n) c[n] = 0u;
              {
                  int n = 0;
#pragma unroll
                  for (int i = 0; i < 16; ++i)
#pragma unroll
                      for (int j = 0; j < 16; ++j)
                          if ((i + 1) * (j + 1) <= 16) { c[n] = score_key8(s1[i] + s2[j], i * 16 + j); ++n; }
              }
              sort16_desc<0>(c); sort16_desc<16>(c); sort16_desc<32>(c); sort16_desc<48>(c);
              unsigned t[16], u[16];
#pragma unroll
              for (int i = 0; i < 16; ++i) { t[i] = max(c[i], c[31 - i]); u[i] = max(c[32 + i], c[63 - i]); }
              bitonic_merge16_desc(t); bitonic_merge16_desc(u);
#pragma unroll
              for (int i = 0; i < 16; ++i) t[i] = max(t[i], u[15 - i]);
              bitonic_merge16_desc(t);
              const float mx = key_score8(t[0]);
              float ex[16], den = 0.f;
#pragma unroll
              for (int k = 0; k < 16; ++k) { ex[k] = __expf(key_score8(t[k]) - mx); den += ex[k]; }
              const float iden = 1.f / den;
#pragma unroll
              for (int k = 0; k < 16; ++k) {
                  const unsigned e1 = l1[(t[k] >> 4) & 15u] & 127u, e2 = l2[t[k] & 15u] & 127u;
                  ekey8[slot * 128 + hd * 16 + k] = e1 * 128u + e2;
                  egate8[slot * 128 + hd * 16 + k] = ex[k] * iden;
              }
          }
      }
#pragma unroll 1
      for (int rnd = 0; rnd < 4; ++rnd) {
        const int tok0 = tokc + rnd * nwaves * TPW;
        if (tok0 >= NTOK) break;
        const unsigned* ekey = ekey8 + rnd * 256; const float* egate = egate8 + rnd * 256;
        cnt[lane] = 0u; cnt[64 + lane] = 0u;
        unsigned mykey[4]; float mygate[4];
#pragma unroll
        for (int j = 0; j < 4; ++j) { mykey[j] = ekey[lane + 64 * j]; mygate[j] = egate[lane + 64 * j]; }
        const unsigned bflip = (rnd & 1) ? 63u : 0u;
#pragma unroll
        for (int j = 0; j < 4; ++j) atomicAdd(&cnt[(j >> 1) * 64 + ((mykey[j] >> 8) ^ bflip)], 1u);
#pragma unroll
        for (int ts = 0; ts < 2; ++ts) {
            const unsigned c = cnt[ts * 64 + lane];
            unsigned incl = c;
#pragma unroll
            for (int d = 1; d < 64; d <<= 1) { const unsigned t = __shfl_up(incl, d); if (lane >= d) incl += t; }
            cnt[ts * 64 + lane] = incl - c;
        }
#pragma unroll
        for (int j = 0; j < 4; ++j) {
            const unsigned pos = atomicAdd(&cnt[(j >> 1) * 64 + ((mykey[j] >> 8) ^ bflip)], 1u);
            skey[(j >> 1) * 128 + pos] = mykey[j]; sgate[(j >> 1) * 128 + pos] = mygate[j];
        }
        f32x2_t hv[TPW][8];
#pragma unroll
        for (int ts = 0; ts < TPW; ++ts) {
            const int tok = tok0 + ts, b = tok / SEQ;
            const float rs = rsqrtf(ss2_row(ss2p, tok) * (1.f / 1024.f) + 1e-6f);
            const u16* xg = (const u16*)(p.ws + OFF_X1G) + (size_t)tok * DM + 16 * lane;
            const float* gsh = mod + b * 6144 + 3072 + 16 * lane;
            float xf[16];
            load8(xg, *(float(*)[8])&xf[0]); load8(xg + 8, *(float(*)[8])&xf[8]);
#pragma unroll
            for (int q = 0; q < 4; ++q) {
                const f32x4 hh = *(const f32x4*)(gsh + 4 * q);
                hv[ts][2 * q].x = xf[4 * q] * rs + hh.x;
                hv[ts][2 * q].y = xf[4 * q + 1] * rs + hh.y;
                hv[ts][2 * q + 1].x = xf[4 * q + 2] * rs + hh.z;
                hv[ts][2 * q + 1].y = xf[4 * q + 3] * rs + hh.w;
            }
        }
        f32x2_t oacc[TPW][8];
#pragma unroll
        for (int ts = 0; ts < TPW; ++ts)
#pragma unroll
            for (int j = 0; j < 8; ++j) oacc[ts][j] = (f32x2_t){0.f, 0.f};
        const int myq = 4 * (lane & 1) + (lane & 2) + ((lane >> 2) & 1);
        const int mypos = (myq >> 2) * 128 + (myq & 3);
        Rows8 ur, vr;
        g8_load(ur, skey, 0, U8, U8, 16384, lane);
#pragma unroll 1
        for (int g = 0; g < 32; ++g) {
            g8_load(vr, skey, g, V8A, V8B, V8_SPLIT, lane);
            const int mye = (int)skey[mypos + 4 * g];
            const float myus = usc[mye], myvs = vsc[mye], mygt = sgate[mypos + 4 * g];
            float d[8];
#pragma unroll
            for (int q = 0; q < 8; ++q) d[q] = g8_dot(ur.r[q], hv[q >> 2]);
            if (g + 1 < 32) g8_load(ur, skey, g + 1, U8, U8, 16384, lane);
            const float tot = g8_reduce(d, lane);
            const int wbits = __builtin_bit_cast(int, mygt * gelu_as(tot * myus) * myvs);
#pragma unroll
            for (int q = 0; q < 8; ++q) {
                const float w = __builtin_bit_cast(float, __builtin_amdgcn_readlane(wbits, ((q >> 2) & 1) + 2 * ((q >> 1) & 1) + 4 * (q & 1)));
                g8_axpy(oacc[q >> 2], w, vr.r[q]);
            }
        }
#pragma unroll
        for (int ts = 0; ts < TPW; ++ts) {
            const int tok = tok0 + ts, b = tok / SEQ;
            const u16* xr = X1 + (size_t)tok * DM + 16 * lane; const float* g2v = mod + b * 6144 + 5120 + 16 * lane;
            float* orow = p.out + (size_t)tok * DM + 16 * lane;
            const u32x4 xw0 = *(const u32x4*)(xr), xw1 = *(const u32x4*)(xr + 8);
            const unsigned xw[8] = {xw0.x, xw0.y, xw0.z, xw0.w, xw1.x, xw1.y, xw1.z, xw1.w};
#pragma unroll
            for (int q = 0; q < 4; ++q) {
                const f32x4 gv = *(const f32x4*)(g2v + 4 * q);
                f32x4 xv; xv.x = bflo(xw[2 * q]); xv.y = bfhi(xw[2 * q]); xv.z = bflo(xw[2 * q + 1]); xv.w = bfhi(xw[2 * q + 1]);
                f32x4 o;
                o.x = xv.x + gv.x * oacc[ts][2 * q].x; o.y = xv.y + gv.y * oacc[ts][2 * q].y;
                o.z = xv.z + gv.z * oacc[ts][2 * q + 1].x; o.w = xv.w + gv.w * oacc[ts][2 * q + 1].y;
                *(f32x4*)(orow + 4 * q) = o;
            }
        }
      }
    }
}

#if defined(__HIP_DEVICE_COMPILE__)
typedef const Params __attribute__((address_space(4)))* KargPtr;
DI Params kargs() { KargPtr k = (KargPtr)__builtin_amdgcn_kernarg_segment_ptr(); asm volatile("" : "+s"(k)); return *k; }
#define PK kargs()
#else
#define PK p
#endif
constexpr int SMEM_BYTES = 79616;
__global__ void __launch_bounds__(256, 2) fwd_megakernel(Params p) {
    cg::grid_group grid = cg::this_grid();
    __shared__ __attribute__((aligned(16))) char smem[SMEM_BYTES];
    __shared__ __attribute__((aligned(16))) unsigned xb_words[4];
    if (threadIdx.x == 0) { xb_words[0] = 0u; xb_words[1] = 0u; xb_words[2] = 0u; xb_words[3] = 0u; }
    __syncthreads();
    XcdBarrier bar = xcd_barrier_post((unsigned*)(p.ws + OFF_BAR), (volatile LAS unsigned*)xb_words);
    const int bid = blockIdx.x, nb = gridDim.x;

    ph0(PK, smem, bid, nb);
    xcd_barrier(bar);
    ph1a(PK, bid, nb);
    xcd_barrier(bar);
    ph1(PK, smem, bid, nb);
    xcd_barrier(bar);
    ph2a(PK, bid, nb);
    ph2b(PK, smem, bid, nb);
    xcd_barrier(bar);
    if (bid < 128 && (threadIdx.x >> 6) == 0) __builtin_amdgcn_s_setprio(2);
    for (int chain = bid; chain < 128; chain += nb) ph3c_chain(PK, smem, chain);
    __builtin_amdgcn_s_setprio(0);
    {
        int abid = bid, anb = nb;
        if (nb > 128) {
            abid = bid - 128; anb = nb - 128;
            if (nb == 512 && abid >= 128) abid = (abid < 256) ? abid + 128 : abid - 128;
        } else xcd_barrier(bar);
        if (abid >= 0) {
            const int rem = (NB * 4 * 32) % anb, cb = rem ? abid - rem : abid, cn = rem ? anb - rem : anb;
            ph2c(PK, smem, abid, anb);
            if (cb >= 0) {
                { const Params pl = PK; convert_fp8_rows(pl.U, pl.ws + OFF_U8, pl.ws + OFF_U8, 16384, (float*)(pl.ws + OFF_USC), cb, cn); }
                { const Params pl = PK; convert_fp8_rows(pl.V, pl.ws + OFF_V8A, pl.ws + OFF_V8B, V8_SPLIT, (float*)(pl.ws + OFF_VSC), cb, cn); }
            }
        }
    }
    xcd_barrier(bar);
    ph4(PK, bid, nb);
    xcd_barrier(bar);
    ph5(PK, smem, bid, nb);
    xcd_barrier(bar);
    ph6(PK, smem, bid, nb);
    xcd_barrier(bar);
    ph7(PK, smem, bid, nb);
}

extern "C" void kernel_launch(void* const* d_in, const int* in_sizes, int n_in,
                              void* d_out, int out_size, void* d_ws, size_t ws_size,
                              hipStream_t stream) {
    static int grid_blocks = 0;
    if (!grid_blocks) {
        int dev = 0, cus = 0, per_cu = 0;
        (void)hipGetDevice(&dev);
        (void)hipDeviceGetAttribute(&cus, hipDeviceAttributeMultiprocessorCount, dev);
        (void)hipOccupancyMaxActiveBlocksPerMultiprocessor(&per_cu, fwd_megakernel, 256, 0);
        if (per_cu > 2) per_cu = 2;
        if (per_cu < 1) per_cu = 1;
        grid_blocks = cus * per_cu;
    }
    (void)hipMemsetAsync(d_ws, 0, 65536, stream);
    Params p{};
    const float** pp = (const float**)&p;
    for (int i = 0; i < 27; ++i) pp[i] = (const float*)d_in[i];
    p.out = (float*)d_out; p.ws = (unsigned char*)d_ws;
    void* args[] = {&p};
    hipError_t e = hipLaunchCooperativeKernel((void*)fwd_megakernel, dim3(grid_blocks), dim3(256), args, 0, stream);
    if (e != hipSuccess) fprintf(stderr, "cooperative launch failed: %s (grid %d)\n", hipGetErrorString(e), grid_blocks);
}
```
